# Optimizing an MI355X kernel written in HIP

```python
import math
import jax, jax.numpy as jnp
from jax import lax
import numpy as np

D_MODEL = 1024
BATCH = 32
SEQ = 256
DEPTH = 4
DEC_BATCH = 2
DEC_SEQ = 1024
PAST_LEN = 512

GRID_W = 64
MIX_WIDTH = D_MODEL
A_WIDTH = MIX_WIDTH // 2
A_HEADS = 4
A_V_DIM = A_WIDTH // A_HEADS
A_QK_DIM = A_V_DIM // 2
B_WIDTH = MIX_WIDTH // 4
C_WIDTH = MIX_WIDTH - A_WIDTH - B_WIDTH
C_GROUPS = 4
C_GROUP_DIM = C_WIDTH // C_GROUPS
CHUNK = 128
CONV_W = 3
D_FF = 4 * D_MODEL
Q_BLOCK = 128
ROPE_BASE = 10000.0
ROPE_AXIS_DIM = A_QK_DIM // 2
IN_WIDTH = 3 * A_WIDTH + 3 * B_WIDTH + 2 * C_WIDTH
EPS = 1e-6

kernel_name = 'hybrid_diffattn_conv_chunkmlp_prefix_dit'


def _rmsnorm(x, g):
    xf = x.astype(jnp.float32)
    y = xf * lax.rsqrt(jnp.mean(xf * xf, axis=-1, keepdims=True) + EPS)
    return (y * g.astype(jnp.float32)).astype(x.dtype)


def _rope_tables(n_tokens):
    rows = n_tokens // GRID_W
    row = jnp.repeat(jnp.arange(rows, dtype=jnp.float32), GRID_W)
    col = jnp.tile(jnp.arange(GRID_W, dtype=jnp.float32), rows)
    inv = ROPE_BASE ** (-jnp.arange(0, ROPE_AXIS_DIM, 2, dtype=jnp.float32) / ROPE_AXIS_DIM)
    ang_r = row[:, None] * inv
    ang_c = col[:, None] * inv
    return (jnp.cos(ang_r), jnp.sin(ang_r), jnp.cos(ang_c), jnp.sin(ang_c))


def _rot_half(x, cos, sin):
    x1, x2 = jnp.split(x, 2, axis=-1)
    return jnp.concatenate([x1 * cos - x2 * sin, x2 * cos + x1 * sin], axis=-1)


def _apply_axial_rope(x, tables):
    cr, sr, cc, sc = tables
    b, t, h, _ = x.shape
    xf = x.astype(jnp.float32).reshape(b, t, h, 2, A_QK_DIM)
    bc = lambda a: a[:, None, None, :]
    xr, xc = jnp.split(xf, 2, axis=-1)
    out = jnp.concatenate([_rot_half(xr, bc(cr), bc(sr)), _rot_half(xc, bc(cc), bc(sc))], axis=-1)
    return out.reshape(b, t, h, 2 * A_QK_DIM).astype(x.dtype)


def _project(h, w_in_l):
    p = h @ w_in_l
    sizes = (A_WIDTH,) * 3 + (B_WIDTH,) * 3 + (C_WIDTH,) * 2
    idx = [int(s) for s in np.cumsum(sizes)[:-1]]
    q, k, v, gb, gc, xin, u, vs = jnp.split(p, idx, axis=-1)
    b, t, _ = h.shape
    q = q.reshape(b, t, A_HEADS, 2 * A_QK_DIM)
    k = k.reshape(b, t, A_HEADS, 2 * A_QK_DIM)
    v = v.reshape(b, t, A_HEADS, A_V_DIM)
    return q, k, v, gb, gc, xin, u, vs


def _diff_attention(q, k, v, lam, subln_g, lam_init):
    b, tq = q.shape[0], q.shape[1]
    tk = k.shape[1]
    n_blk = tq // Q_BLOCK
    k2 = k.reshape(b, tk, A_HEADS, 2, A_QK_DIM)
    qb = q.reshape(b, n_blk, Q_BLOCK, A_HEADS, 2, A_QK_DIM).transpose(1, 0, 2, 3, 4, 5)
    scale = A_QK_DIM ** -0.5

    def one_block(qblk):
        s = jnp.einsum('bqhcd,bkhcd->bchqk', qblk, k2, preferred_element_type=jnp.float32) * scale
        p = jax.nn.softmax(s, axis=-1)
        a = p[:, 0] - lam * p[:, 1]
        return jnp.einsum('bhqk,bkhd->bqhd', a.astype(v.dtype), v)

    o = lax.map(one_block, qb)
    o = o.transpose(1, 0, 2, 3, 4).reshape(b, tq, A_HEADS, A_V_DIM)
    o = _rmsnorm(o, subln_g) * (1.0 - lam_init)
    return o.reshape(b, tq, A_WIDTH)


def _short_conv(x, w, bias):
    xp = jnp.pad(x, ((0, 0), (1, 1), (0, 0)))
    return xp[:, :-2] * w[0] + xp[:, 1:-1] * w[1] + xp[:, 2:] * w[2] + bias


def _chunk_mlp(u, vs, w_s, b_s):
    b, t, _ = vs.shape
    vc = vs.reshape(b, t // CHUNK, CHUNK, C_GROUPS, C_GROUP_DIM)
    mixed = jnp.einsum('gpq,bnqgd->bnpgd', w_s, vc) + b_s.T[None, None, :, :, None]
    return u * mixed.reshape(b, t, C_WIDTH)


def _lambda(lq1, lk1, lq2, lk2, lam_init):
    f = lambda a: a.astype(jnp.float32)
    return jnp.exp(jnp.sum(f(lq1) * f(lk1))) - jnp.exp(jnp.sum(f(lq2) * f(lk2))) + lam_init


def _mlp(h, w_up_l, w_down_l):
    a = jax.nn.relu(h @ w_up_l)
    return (a * a) @ w_down_l


def setup_inputs(seed: int = 0) -> dict:
    key = jax.random.key(seed)
    ks = jax.random.split(key, 24)
    n = lambda k, s, sc: jax.random.normal(k, s, jnp.float32) * sc
    return {
        'x_prompt': n(ks[0], (BATCH, SEQ, D_MODEL), 1.0),
        'x_sample': n(ks[1], (DEC_BATCH, DEC_SEQ, D_MODEL), 1.0),
        'cache_k': n(ks[2], (DEC_BATCH, DEPTH, PAST_LEN, A_HEADS, 2 * A_QK_DIM), 1.0),
        'cache_v': n(ks[3], (DEC_BATCH, DEPTH, PAST_LEN, A_HEADS, A_V_DIM), 1.0),
        'c': n(ks[4], (DEC_BATCH, D_MODEL), 1.0),
        'c_ctx': n(ks[5], (D_MODEL,), 1.0),
        'w_mod': n(ks[6], (DEPTH, D_MODEL, 6 * D_MODEL), 0.5 * D_MODEL ** -0.5),
        'b_mod': n(ks[7], (DEPTH, 6 * D_MODEL), 0.02),
        'norm_mix': 1.0 + n(ks[8], (DEPTH, D_MODEL), 0.02),
        'norm_mlp': 1.0 + n(ks[9], (DEPTH, D_MODEL), 0.02),
        'w_in': n(ks[10], (DEPTH, D_MODEL, IN_WIDTH), D_MODEL ** -0.5),
        'lam_q1': n(ks[11], (DEPTH, A_QK_DIM), 0.1),
        'lam_k1': n(ks[12], (DEPTH, A_QK_DIM), 0.1),
        'lam_q2': n(ks[13], (DEPTH, A_QK_DIM), 0.1),
        'lam_k2': n(ks[14], (DEPTH, A_QK_DIM), 0.1),
        'subln': 1.0 + n(ks[15], (DEPTH, A_V_DIM), 0.02),
        'conv_w': n(ks[16], (DEPTH, CONV_W, B_WIDTH), CONV_W ** -0.5),
        'conv_b': n(ks[17], (DEPTH, B_WIDTH), 0.02),
        'w_s': n(ks[18], (DEPTH, C_GROUPS, CHUNK, CHUNK), CHUNK ** -0.5),
        'b_s': 1.0 + n(ks[19], (DEPTH, C_GROUPS, CHUNK), 0.02),
        'w_out': n(ks[20], (DEPTH, MIX_WIDTH, D_MODEL), MIX_WIDTH ** -0.5),
        'w_up': n(ks[21], (DEPTH, D_MODEL, D_FF), D_MODEL ** -0.5),
        'w_down': n(ks[22], (DEPTH, D_FF, D_MODEL), D_FF ** -0.5),
        'norm_final': 1.0 + n(ks[23], (D_MODEL,), 0.02),
    }


def reference(x_prompt, x_sample, cache_k, cache_v, c, c_ctx, w_mod, b_mod, norm_mix, norm_mlp,
              w_in, lam_q1, lam_k1, lam_q2, lam_k2, subln, conv_w, conv_b, w_s, b_s,
              w_out, w_up, w_down, norm_final):
    xp = x_prompt
    xs = x_sample
    rope = _rope_tables(xs.shape[1])
    sc_ctx = jax.nn.silu(c_ctx)
    sc_lat = jax.nn.silu(c)
    new_k, new_v = [], []
    for d in range(DEPTH):
        lam_init = 0.8 - 0.6 * math.exp(-0.3 * d)
        lam = _lambda(lam_q1[d], lam_k1[d], lam_q2[d], lam_k2[d], lam_init)

        mod_p = sc_ctx @ w_mod[d] + b_mod[d]
        sa, ca, ga, sm, cm, gm = jnp.split(mod_p, 6, axis=-1)
        h = _rmsnorm(xp, norm_mix[d]) * (1.0 + ca) + sa
        q, k, v, gb, gc, xin, u, vs = _project(h, w_in[d])
        att = _diff_attention(q, k, v, lam, subln[d], lam_init)
        conv = gb * _short_conv(gc * xin, conv_w[d], conv_b[d])
        cmlp = _chunk_mlp(u, vs, w_s[d], b_s[d])
        xp = xp + ga * (jnp.concatenate([att, conv, cmlp], axis=-1) @ w_out[d])
        h = _rmsnorm(xp, norm_mlp[d]) * (1.0 + cm) + sm
        xp = xp + gm * _mlp(h, w_up[d], w_down[d])
        new_k.append(k)
        new_v.append(v)

        mod_s = (sc_lat @ w_mod[d] + b_mod[d])[:, None, :]
        sa, ca, ga, sm, cm, gm = jnp.split(mod_s, 6, axis=-1)
        h = _rmsnorm(xs, norm_mix[d]) * (1.0 + ca) + sa
        q, k, v, gb, gc, xin, u, vs = _project(h, w_in[d])
        q = _apply_axial_rope(q, rope)
        k = _apply_axial_rope(k, rope)
        k_all = jnp.concatenate([cache_k[:, d].astype(k.dtype), k], axis=1)
        v_all = jnp.concatenate([cache_v[:, d].astype(v.dtype), v], axis=1)
        att = _diff_attention(q, k_all, v_all, lam, subln[d], lam_init)
        conv = gb * _short_conv(gc * xin, conv_w[d], conv_b[d])
        cmlp = _chunk_mlp(u, vs, w_s[d], b_s[d])
        xs = xs + ga * (jnp.concatenate([att, conv, cmlp], axis=-1) @ w_out[d])
        h = _rmsnorm(xs, norm_mlp[d]) * (1.0 + cm) + sm
        xs = xs + gm * _mlp(h, w_up[d], w_down[d])

    y_prompt = _rmsnorm(xp, norm_final)
    y_sample = _rmsnorm(xs, norm_final)
    new_cache_k = jnp.stack(new_k, axis=1)
    new_cache_v = jnp.stack(new_v, axis=1)
    return (y_prompt, y_sample, new_cache_k, new_cache_v)
```

```cpp
#include <hip/hip_runtime.h>
#include <hip/hip_cooperative_groups.h>
#include <cstdio>
#include <cstdint>
namespace cg = cooperative_groups;
#ifndef MULTI_LAUNCH
#define MULTI_LAUNCH 0
#endif
namespace pg8 {
#define PG8_LAS __attribute__((address_space(3)))
typedef unsigned short bf16_t;
typedef short bf16x8 __attribute__((ext_vector_type(8)));
typedef float f32x4 __attribute__((ext_vector_type(4)));
typedef unsigned u32x4 __attribute__((ext_vector_type(4)));
constexpr int BM = 256, BK = 64, HALF = 128, HTB = HALF * BK * 2  , STAGE_BYTES = 8 * HTB, NXCD = 8, WGM = 8;

__host__ __device__ __forceinline__ int lds_byte(int r, int c) { const int st = (r >> 4) * 2 + (c >> 5), rr = r & 15, cc = c & 31, ob = rr * 64 + cc * 2; return st * 1024 + (ob ^ (((ob >> 9) & 1) << 5)); }
__host__ __device__ __forceinline__ void stage_rc(int b, int& R, int& C) { const int st = b / 1024, sb = b % 1024, swz = sb ^ (((sb >> 9) & 1) << 5); R = (st >> 1) * 16 + swz / 64; C = (st & 1) * 32 + (swz % 64) / 2; }
__host__ __device__ __forceinline__ int perm32(int rho) { const int n = rho >> 4, i = rho & 15; return 8 * (i >> 2) + 4 * n + (i & 3); }

struct Unit { int pm, pn; };
struct Gemm { const bf16_t* A; const bf16_t* Bt; int M, N, K; };

struct StaticOrder {
    int nM, nN, nwg, G, c;
    __host__ __device__ void init(int M, int N, int G_, int c_) { nM = M / BM; nN = N / BM; nwg = nM * nN; G = G_; c = c_; }
    __host__ __device__ bool next(int i, Unit& u) const {
        const long L = (long)i * G + c; if (L >= nwg) return false;
        int wgid = (int)L; { const int q = nwg / NXCD, r = nwg % NXCD, xcd = wgid % NXCD, off = wgid / NXCD; wgid = (xcd < r ? xcd * (q + 1) : r * (q + 1) + (xcd - r) * q) + off; }
        const int nig = WGM * nN, gid = wgid / nig, fm = gid * WGM, gsz = (nM - fm) < WGM ? (nM - fm) : WGM;
        u.pm = fm + ((wgid % nig) % gsz); u.pn = (wgid % nig) / gsz; return true;
    }
    __device__ __forceinline__ void a_ready(const Unit&) const {}
    __device__ __forceinline__ void done(const Unit&) const {}
};

__device__ __forceinline__ unsigned cvt_pk_bf16(float lo, float hi) { unsigned r; asm volatile("v_cvt_pk_bf16_f32 %0, %1, %2" : "=v"(r) : "v"(lo), "v"(hi)); return r; }
typedef unsigned u32x2 __attribute__((ext_vector_type(2)));
typedef float f32x2_t __attribute__((ext_vector_type(2))); typedef __bf16 bf16x2_t __attribute__((ext_vector_type(2)));
__device__ __forceinline__ unsigned cvtpk(float lo, float hi) { f32x2_t v = {lo, hi}; bf16x2_t b = __builtin_convertvector(v, bf16x2_t); return __builtin_bit_cast(unsigned, b); }
constexpr float QSCALE = 0.125f * 1.4426950408889634f;

struct EpiIn {
    static constexpr bool PERM = false, AFTER_DRAIN = false;
    unsigned char* ws; float* out; int layer;
    static __device__ __forceinline__ bool swapped(const Unit& u) { return u.pn == 4 || u.pn == 5 || u.pn == 10; }
    __device__ __forceinline__ void operator()(const f32x4 (&acc)[2][2][4][2], const Unit& u, int wr, int wc, int fr, int fq) const {
        const int pn = u.pn, pm = u.pm;
        bf16_t* P = (bf16_t*)(ws + (176u << 20)); bf16_t* KL = (bf16_t*)(ws + (116u << 20)) + (size_t)layer * (2 * 1536 * 512); bf16_t* VtC = (bf16_t*)(ws + (140u << 20));
        bf16_t* VtL = (bf16_t*)(ws + (128u << 20)) + (size_t)layer * (2 * 512 * 1536); bf16_t* VsT = (bf16_t*)(ws + (148u << 20));
        float* ck = out + (size_t)10240 * 1024; float* cv = ck + (size_t)32 * 4 * 256 * 512; const float* rc = (const float*)(ws + (1u << 20) + 512 * 1024); const float* rs = rc + 1024;
        if (pn == 4 || pn == 5 || pn == 10) {
#pragma unroll
            for (int ai = 0; ai < 2; ++ai)
#pragma unroll
                for (int m = 0; m < 4; ++m) {
                    const int R = (pn == 10 ? 0 : (pn - 4) * 256) + ai * 128 + wr * 64 + m * 16 + fr;
#pragma unroll
                    for (int bj = 0; bj < 2; ++bj)
#pragma unroll
                        for (int n = 0; n < 2; ++n) {
                            const int tl = bj * 128 + wc * 32 + n * 16 + 4 * fq;
                            const f32x4 v = acc[ai][bj][m][n]; u32x2 w; w.x = cvtpk(v[0], v[1]); w.y = cvtpk(v[2], v[3]);
                            if (pn == 10) *(u32x2*)(VsT + (size_t)R * 10240 + pm * 256 + tl) = w;
                            else if (pm < 32) { *(u32x2*)(VtC + (size_t)(pm * 512 + R) * 256 + tl) = w;
                                float* o = cv + (size_t)((pm * 4 + layer) * 256 + tl) * 512 + R; o[0] = v[0]; o[512] = v[1]; o[1024] = v[2]; o[1536] = v[3]; }
                            else { const int b = (pm - 32) >> 2, t = ((pm - 32) & 3) * 256 + tl; *(u32x2*)(VtL + (size_t)(b * 512 + R) * 1536 + 512 + t) = w; }
                        }
                }
            return;
        }
        const int row0 = pm * 256 + wr * 64 + fr, colt = pn * 256 + wc * 32 + 4 * fq;
        if (pn < 4) {
            const bool isq = pn < 2; const float sc = isq ? QSCALE : 1.f;
            if (pm < 32) {
#pragma unroll
                for (int ai = 0; ai < 2; ++ai)
#pragma unroll
                    for (int m = 0; m < 4; ++m) { const int row = row0 + ai * 128 + m * 16;
#pragma unroll
                        for (int bj = 0; bj < 2; ++bj)
#pragma unroll
                            for (int n = 0; n < 2; ++n) { const int col = colt + bj * 128 + n * 16; const f32x4 a = acc[ai][bj][m][n]; const f32x4 v = a * sc;
                                u32x2 w; w.x = cvtpk(v[0], v[1]); w.y = cvtpk(v[2], v[3]); *(u32x2*)(P + (size_t)row * 2816 + col) = w;
                                if (!isq) *(f32x4*)(ck + (size_t)((pm * 4 + layer) * 256 + (row & 255)) * 512 + (col - 512)) = a; } }
            } else {
                const int b = (pm - 32) >> 2;
#pragma unroll
                for (int ai = 0; ai < 2; ++ai)
#pragma unroll
                    for (int m = 0; m < 4; ++m) { const int row = row0 + ai * 128 + m * 16; const int tpos = (row - 8192) & 1023; const int pos = (wc & 1) ? (tpos & 63) : (tpos >> 6);
                        const f32x4 cs = *(const f32x4*)(rc + pos * 16 + 4 * fq), sn = *(const f32x4*)(rs + pos * 16 + 4 * fq);
#pragma unroll
                        for (int bj = 0; bj < 2; ++bj) { const f32x4 x1 = acc[ai][bj][m][0], x2 = acc[ai][bj][m][1];
                            const f32x4 o1 = (x1 * cs - x2 * sn) * sc, o2 = (x2 * cs + x1 * sn) * sc; const int col = colt + bj * 128;
                            u32x2 w1, w2; w1.x = cvtpk(o1[0], o1[1]); w1.y = cvtpk(o1[2], o1[3]); w2.x = cvtpk(o2[0], o2[1]); w2.y = cvtpk(o2[2], o2[3]);
                            bf16_t* dst = isq ? (P + (size_t)row * 2816 + col) : (KL + (size_t)(b * 1536 + 512 + tpos) * 512 + (col - 512));
                            *(u32x2*)dst = w1; *(u32x2*)(dst + 16) = w2; } }
            }
        } else {
#pragma unroll
            for (int ai = 0; ai < 2; ++ai)
#pragma unroll
                for (int m = 0; m < 4; ++m) { const int row = row0 + ai * 128 + m * 16;
#pragma unroll
                    for (int bj = 0; bj < 2; ++bj)
#pragma unroll
                        for (int n = 0; n < 2; ++n) { const int col = colt + bj * 128 + n * 16; const f32x4 v = acc[ai][bj][m][n];
                            u32x2 w; w.x = cvtpk(v[0], v[1]); w.y = cvtpk(v[2], v[3]); *(u32x2*)(P + (size_t)row * 2816 + col) = w; } }
        }
    }
};
struct EpiRes {
    static constexpr bool PERM = false, AFTER_DRAIN = false;
    const float* xp; const float* xs; float* xbuf; const float* gate_base; int first;
    static __device__ __forceinline__ bool swapped(const Unit&) { return false; }
    __device__ __forceinline__ void operator()(const f32x4 (&acc)[2][2][4][2], const Unit& u, int wr, int wc, int fr, int fq) const {
        const int s = u.pm < 32 ? 0 : 1 + ((u.pm - 32) >> 2); const float* gate = gate_base + s * 6144;
        const int col0 = u.pn * 256 + wc * 32 + 4 * fq;
        f32x4 gv[2][2];
#pragma unroll
        for (int bj = 0; bj < 2; ++bj)
#pragma unroll
            for (int n = 0; n < 2; ++n) gv[bj][n] = *(const f32x4*)(gate + col0 + bj * 128 + n * 16);
#pragma unroll
        for (int ai = 0; ai < 2; ++ai)
#pragma unroll
            for (int m = 0; m < 4; ++m) { const int row = u.pm * 256 + ai * 128 + wr * 64 + m * 16 + fr;
                const float* src = first ? (row < 8192 ? xp + (size_t)row * 1024 : xs + (size_t)(row - 8192) * 1024) : xbuf + (size_t)row * 1024; float* dst = xbuf + (size_t)row * 1024;
#pragma unroll
                for (int bj = 0; bj < 2; ++bj)
#pragma unroll
                    for (int n = 0; n < 2; ++n) { const int c = col0 + bj * 128 + n * 16; *(f32x4*)(dst + c) = *(const f32x4*)(src + c) + gv[bj][n] * acc[ai][bj][m][n]; } }
    }
};
struct EpiUp {
    static constexpr bool PERM = true, AFTER_DRAIN = false;
    bf16_t* O; int ldc;
    static __device__ __forceinline__ bool swapped(const Unit&) { return false; }
    __device__ __forceinline__ void operator()(const f32x4 (&acc)[2][2][4][2], const Unit& u, int wr, int wc, int fr, int fq) const {
        const int row0 = u.pm * 256 + wr * 64 + fr, col0 = u.pn * 256 + wc * 32 + 8 * fq;
#pragma unroll
        for (int ai = 0; ai < 2; ++ai)
#pragma unroll
            for (int m = 0; m < 4; ++m) { bf16_t* rowp = O + (size_t)(row0 + ai * 128 + m * 16) * ldc + col0;
#pragma unroll
                for (int bj = 0; bj < 2; ++bj) { f32x4 v0 = acc[ai][bj][m][0], v1 = acc[ai][bj][m][1];
#pragma unroll
                    for (int e = 0; e < 4; ++e) { const float a = fmaxf(v0[e], 0.f), b = fmaxf(v1[e], 0.f); v0[e] = a * a; v1[e] = b * b; }
                    u32x4 w; w.x = cvtpk(v0[0], v0[1]); w.y = cvtpk(v0[2], v0[3]); w.z = cvtpk(v1[0], v1[1]); w.w = cvtpk(v1[2], v1[3]);
                    *(u32x4*)(rowp + bj * 128) = w; } }
    }
};
template <class Epi, class Sched, bool ALIGN_EPI = false, bool SP2 = false>
__device__ __forceinline__ void gemm_phase(PG8_LAS unsigned char* lds, const Gemm g, const Sched& S, const Epi& E, int wave_s) {
    int tid_l; asm volatile("v_mbcnt_lo_u32_b32 %0, -1, 0\n\tv_mbcnt_hi_u32_b32 %0, -1, %0" : "=v"(tid_l)); tid_l += wave_s * 64;
    const int tid = tid_l, wid = __builtin_amdgcn_readfirstlane(tid >> 6), lane = tid & 63, wr = wid >> 2, wc = wid & 3, fr = lane & 15, fq = lane >> 4;
    const int K = g.K, nt = K / BK;
    unsigned voffA[2], voffB[2];
#pragma unroll
    for (int i = 0; i < 2; ++i) { int R, C; stage_rc(tid * 16 + i * 8192, R, C); const int Rb = Epi::PERM ? ((R & ~31) + perm32(R & 31)) : R;
        voffA[i] = (unsigned)(R * K + C) * 2u; voffB[i] = (unsigned)(Rb * K + C) * 2u; }
    const size_t kstep = (size_t)(BK * 2);
    const size_t hstep = (size_t)HALF * K * 2;
    const size_t tstep = 2 * hstep;
    const unsigned ldsw = (unsigned)wid * 1024u;
    const int aoff = lds_byte(wr * 64 + fr, fq * 8), boff = lds_byte(wc * 32 + fr, fq * 8);
#define PG8_SA(b, h) (((b) * 2 + (h)) * HTB)
#define PG8_SB(b, h) ((4 + (b) * 2 + (h)) * HTB)
#define PG8_STAGE(bufoff, gbase, voff) do { _Pragma("unroll") for (int _i = 0; _i < 2; ++_i) \
        __builtin_amdgcn_global_load_lds((const unsigned*)((const char*)(gbase) + (voff)[_i]), (PG8_LAS unsigned*)(lds + (bufoff) + ldsw + _i * 8192), 16, 0, 0); } while (0)
#define PG8_LDA(dst, b, h) do { _Pragma("unroll") for (int m = 0; m < 4; ++m) _Pragma("unroll") for (int k = 0; k < 2; ++k) dst[m][k] = *(const PG8_LAS bf16x8*)(lds + PG8_SA(b, h) + aoff + m * 2048 + k * 1024); } while (0)
#define PG8_LDB(dst, b, h) do { _Pragma("unroll") for (int n = 0; n < 2; ++n) _Pragma("unroll") for (int k = 0; k < 2; ++k) dst[n][k] = *(const PG8_LAS bf16x8*)(lds + PG8_SB(b, h) + boff + n * 2048 + k * 1024); } while (0)
#define PG8_MMA(ai, bj, At, Bt) do { __builtin_amdgcn_s_setprio(1); _Pragma("unroll") for (int m = 0; m < 4; ++m) _Pragma("unroll") for (int n = 0; n < 2; ++n) _Pragma("unroll") for (int k = 0; k < 2; ++k) \
        acc[ai][bj][m][n] = __builtin_amdgcn_mfma_f32_16x16x32_bf16(Bt[n][k], At[m][k], acc[ai][bj][m][n], 0, 0, 0); __builtin_amdgcn_s_setprio(0); } while (0)
#define PG8_WAIT_V(n) asm volatile("s_waitcnt vmcnt(" #n ")" ::: "memory")
#define PG8_WAIT_L(n) asm volatile("s_waitcnt lgkmcnt(" #n ")" ::: "memory")
#define PG8_BAR __builtin_amdgcn_s_barrier()
#define PG8_SCHED __builtin_amdgcn_sched_barrier(0)
    Unit cur, nxt; int ui = 0;
    if (!S.next(0, cur)) return;
    f32x4 acc[2][2][4][2];
#pragma unroll
    for (int a = 0; a < 2; ++a)
#pragma unroll
        for (int b = 0; b < 2; ++b)
#pragma unroll
            for (int m = 0; m < 4; ++m)
#pragma unroll
                for (int n = 0; n < 2; ++n) acc[a][b][m][n] = (f32x4){0.f, 0.f, 0.f, 0.f};
    bf16x8 At[4][2], B0[2][2], B1[2][2];
    const char* cA = (const char*)g.A + (size_t)cur.pm * tstep; const char* cB = (const char*)g.Bt + (size_t)cur.pn * tstep;
    if (Epi::swapped(cur)) { const char* t_ = cA; cA = cB; cB = t_; }
    S.a_ready(cur);
    if constexpr (SP2) {
        PG8_STAGE(PG8_SB(0, 0), cB, voffB); PG8_STAGE(PG8_SB(0, 1), cB + hstep, voffB); PG8_STAGE(PG8_SA(0, 0), cA, voffA); PG8_STAGE(PG8_SA(0, 1), cA + hstep, voffA);
        if (wr == 1) PG8_BAR;
        PG8_WAIT_V(2); PG8_BAR;
        PG8_STAGE(PG8_SB(1, 0), cB + kstep, voffB); PG8_STAGE(PG8_SA(1, 0), cA + kstep, voffA); PG8_STAGE(PG8_SB(1, 1), cB + hstep + kstep, voffB);
        PG8_WAIT_V(6); PG8_BAR;
    } else {
        PG8_STAGE(PG8_SB(0, 0), cB, voffB); PG8_STAGE(PG8_SA(0, 0), cA, voffA); PG8_STAGE(PG8_SB(0, 1), cB + hstep, voffB); PG8_STAGE(PG8_SA(0, 1), cA + hstep, voffA);
        if (wr == 1) PG8_BAR;
        PG8_WAIT_V(4); PG8_BAR;
        PG8_STAGE(PG8_SB(1, 0), cB + kstep, voffB); PG8_STAGE(PG8_SA(1, 0), cA + kstep, voffA); PG8_STAGE(PG8_SB(1, 1), cB + hstep + kstep, voffB);
        PG8_WAIT_V(6); PG8_BAR;
    }
    for (;;) {
        const bool has_next = S.next(ui + 1, nxt);
        const char* nA = has_next ? (const char*)g.A + (size_t)nxt.pm * tstep : cA; const char* nB = has_next ? (const char*)g.Bt + (size_t)nxt.pn * tstep : cB;
        if (has_next && Epi::swapped(nxt)) { const char* t_ = nA; nA = nB; nB = t_; }
        for (int t = 0; t < nt; t += 2) {
            const bool last = (t == nt - 2);
            const char* a1 = cA + (size_t)(t + 1) * kstep;
            const char* a2 = last ? nA : cA + (size_t)(t + 2) * kstep; const char* b2 = last ? nB : cB + (size_t)(t + 2) * kstep;
            const char* a3 = a2 + kstep; const char* b3 = b2 + kstep;
            if (last && has_next) S.a_ready(nxt);
            if constexpr (SP2) {
            PG8_LDB(B0, 0, 0); PG8_LDB(B1, 0, 1); PG8_SCHED; PG8_LDA(At, 0, 0); PG8_STAGE(PG8_SA(1, 1), a1 + hstep, voffA);
            PG8_WAIT_V(8); PG8_WAIT_L(0); PG8_BAR; PG8_MMA(0, 0, At, B0); PG8_MMA(0, 1, At, B1); PG8_BAR; PG8_SCHED;
            PG8_LDA(At, 0, 1); PG8_STAGE(PG8_SB(0, 0), b2, voffB); PG8_STAGE(PG8_SB(0, 1), b2 + hstep, voffB); PG8_STAGE(PG8_SA(0, 0), a2, voffA);
            PG8_WAIT_V(8); PG8_WAIT_L(0); PG8_BAR; PG8_MMA(1, 0, At, B0); PG8_MMA(1, 1, At, B1); PG8_BAR; PG8_SCHED;
            PG8_LDB(B0, 1, 0); PG8_LDB(B1, 1, 1); PG8_SCHED; PG8_LDA(At, 1, 0); PG8_STAGE(PG8_SA(0, 1), a2 + hstep, voffA);
            PG8_WAIT_V(8); PG8_WAIT_L(0); PG8_BAR; PG8_MMA(0, 0, At, B0); PG8_MMA(0, 1, At, B1); PG8_BAR; PG8_SCHED;
            PG8_LDA(At, 1, 1); PG8_STAGE(PG8_SB(1, 0), b3, voffB); PG8_STAGE(PG8_SB(1, 1), b3 + hstep, voffB); PG8_STAGE(PG8_SA(1, 0), a3, voffA);
            PG8_WAIT_V(8); PG8_WAIT_L(0); PG8_BAR; PG8_MMA(1, 0, At, B0); PG8_MMA(1, 1, At, B1); PG8_BAR; PG8_SCHED;
            } else {
            PG8_LDB(B0, 0, 0); PG8_SCHED; PG8_LDA(At, 0, 0); PG8_STAGE(PG8_SA(1, 1), a1 + hstep, voffA);
            PG8_WAIT_L(8); PG8_BAR; PG8_WAIT_L(0); PG8_MMA(0, 0, At, B0); PG8_BAR; PG8_SCHED;
            PG8_LDB(B1, 0, 1); PG8_STAGE(PG8_SB(0, 0), b2, voffB);
            PG8_BAR; PG8_WAIT_L(0); PG8_MMA(0, 1, At, B1); PG8_BAR;
            PG8_LDA(At, 0, 1); PG8_STAGE(PG8_SA(0, 0), a2, voffA);
            PG8_BAR; PG8_WAIT_L(0); PG8_MMA(1, 0, At, B0); PG8_BAR; PG8_SCHED;
            PG8_STAGE(PG8_SB(0, 1), b2 + hstep, voffB);
            PG8_WAIT_V(6); PG8_BAR; PG8_MMA(1, 1, At, B1); PG8_BAR;
            PG8_LDB(B0, 1, 0); PG8_SCHED; PG8_LDA(At, 1, 0); PG8_STAGE(PG8_SA(0, 1), a2 + hstep, voffA);
            PG8_WAIT_L(8); PG8_BAR; PG8_WAIT_L(0); PG8_MMA(0, 0, At, B0); PG8_BAR; PG8_SCHED;
            PG8_LDB(B1, 1, 1); PG8_STAGE(PG8_SB(1, 0), b3, voffB);
            PG8_BAR; PG8_WAIT_L(0); PG8_MMA(0, 1, At, B1); PG8_BAR;
            PG8_LDA(At, 1, 1); PG8_STAGE(PG8_SA(1, 0), a3, voffA);
            PG8_BAR; PG8_WAIT_L(0); PG8_MMA(1, 0, At, B0); PG8_BAR; PG8_SCHED;
            PG8_STAGE(PG8_SB(1, 1), b3 + hstep, voffB);
            PG8_WAIT_V(6); PG8_BAR; PG8_MMA(1, 1, At, B1); PG8_BAR;
            }
        }
        if constexpr (ALIGN_EPI) { if (wr == 0) PG8_BAR; }
        if constexpr (!Epi::AFTER_DRAIN) { E(acc, cur, wr, wc, fr, fq); S.done(cur); }
        if (!has_next) break;
#pragma unroll
        for (int a = 0; a < 2; ++a)
#pragma unroll
            for (int b = 0; b < 2; ++b)
#pragma unroll
                for (int m = 0; m < 4; ++m)
#pragma unroll
                    for (int n = 0; n < 2; ++n) acc[a][b][m][n] = (f32x4){0.f, 0.f, 0.f, 0.f};
        cur = nxt; cA = nA; cB = nB; ++ui;
        if constexpr (ALIGN_EPI) { if (wr == 1) PG8_BAR; }
    }
    PG8_WAIT_V(0);
    if constexpr (!ALIGN_EPI) { if (wr == 0) PG8_BAR; }
    PG8_BAR;
    if constexpr (Epi::AFTER_DRAIN) { E.fused(acc, cur, wr, wc, fr, fq, lds, wid, lane); S.done(cur); }
#undef PG8_SA
#undef PG8_SB
#undef PG8_STAGE
#undef PG8_LDA
#undef PG8_LDB
#undef PG8_MMA
#undef PG8_WAIT_V
#undef PG8_WAIT_L
#undef PG8_BAR
#undef PG8_SCHED
}
}

#define LAS __attribute__((address_space(3)))
typedef unsigned short bf16_t;
typedef short bf16x8 __attribute__((ext_vector_type(8)));
typedef float f32x4 __attribute__((ext_vector_type(4)));
typedef float f32x16 __attribute__((ext_vector_type(16)));
typedef unsigned u32x4 __attribute__((ext_vector_type(4)));
typedef unsigned u32x2 __attribute__((ext_vector_type(2)));
using pg8::cvtpk;

constexpr int NTOK = 10240, NCTX = 8192, DM = 1024, INW = 2816, DFF = 4096, NLAYER = 4;
constexpr int LDS_BYTES = 147456;
constexpr size_t MiB = 1u << 20;
constexpr size_t WS_MOD = 1 * MiB, WS_ROPE = WS_MOD + 512 * 1024, WS_WIN = 2 * MiB, WS_WOUT = 24 * MiB, WS_WUP = 32 * MiB, WS_WDN = 64 * MiB, WS_H = 96 * MiB,
                 WS_KL = 116 * MiB, WS_VTL = 128 * MiB, WS_VTC = 140 * MiB, WS_VST = 148 * MiB, WS_MIX = 154 * MiB, WS_P = 176 * MiB, WS_A = 154 * MiB, WS_END = 234 * MiB;
constexpr size_t WIN_L = (size_t)INW * DM, WOUT_L = (size_t)DM * DM, WUP_L = (size_t)DFF * DM, WDN_L = (size_t)DM * DFF;
constexpr size_t KL_L = (size_t)2 * 1536 * 512, VTL_L = (size_t)2 * 512 * 1536;

struct Params {
    const float *x_prompt, *x_sample, *cache_k, *cache_v, *c, *c_ctx, *w_mod, *b_mod, *norm_mix, *norm_mlp, *w_in, *lam_q1, *lam_k1, *lam_q2, *lam_k2, *subln,
                *conv_w, *conv_b, *w_s, *b_s, *w_out, *w_up, *w_down, *norm_final;
    float* out; unsigned char* ws;
    long long ph_lo, ph_hi;
};

__device__ __forceinline__ float wave_sum(float v) {
#pragma unroll
    for (int o = 1; o < 64; o <<= 1) v += __shfl_xor(v, o);
    return v;
}
__device__ __forceinline__ float xhalf_max(float v) { auto rr = __builtin_amdgcn_permlane32_swap(__float_as_uint(v), __float_as_uint(v), false, false); return fmaxf(__uint_as_float(rr[0]), __uint_as_float(rr[1])); }
__device__ __forceinline__ float xhalf_sum(float v) { auto rr = __builtin_amdgcn_permlane32_swap(__float_as_uint(v), __float_as_uint(v), false, false); return __uint_as_float(rr[0]) + __uint_as_float(rr[1]); }
__device__ __forceinline__ float bf2f(unsigned short b) { return __uint_as_float((unsigned)b << 16); }

__device__ __forceinline__ void transpose_item(const float* W, int N, bf16_t* WT, int ldo, LAS float* scr, int item, int lane) {
    const int nblk = N / 32, kb = item / nblk, nb = item % nblk, k0 = 64 * kb, n0 = 32 * nb;
#pragma unroll 8
    for (int i = 0; i < 32; ++i) { const int kk = 2 * i + (lane >> 5); scr[kk * 33 + (lane & 31)] = W[(size_t)(k0 + kk) * N + n0 + (lane & 31)]; }
    asm volatile("s_waitcnt lgkmcnt(0)" ::: "memory");
    const int c = lane & 7;
#pragma unroll
    for (int j = 0; j < 4; ++j) { const int n = (lane >> 3) + 8 * j; const LAS float* s = scr + (8 * c) * 33 + n;
        u32x4 o; o.x = cvtpk(s[0 * 33], s[1 * 33]); o.y = cvtpk(s[2 * 33], s[3 * 33]); o.z = cvtpk(s[4 * 33], s[5 * 33]); o.w = cvtpk(s[6 * 33], s[7 * 33]);
        *(u32x4*)(WT + (size_t)(n0 + n) * ldo + k0 + 8 * c) = o; }
    asm volatile("s_waitcnt lgkmcnt(0)" ::: "memory");
}

constexpr int STASH_OFF = 144000;
__device__ __forceinline__ const float* ld_param(LAS unsigned char* lds, int i) {
    unsigned off = STASH_OFF; asm volatile("" : "+s"(off));
    volatile LAS unsigned* s = (volatile LAS unsigned*)(lds + off) + 2 * i; unsigned lo = s[0], hi = s[1];
    lo = __builtin_amdgcn_readfirstlane(lo); hi = __builtin_amdgcn_readfirstlane(hi);
    return (const float*)(((unsigned long long)hi << 32) | (unsigned long long)lo);
}
__device__ __forceinline__ Params load_params(LAS unsigned char* lds, unsigned char* ws, float* out) {
    Params q; q.x_prompt = ld_param(lds, 0); q.x_sample = ld_param(lds, 1); q.cache_k = ld_param(lds, 2); q.cache_v = ld_param(lds, 3); q.c = ld_param(lds, 4); q.c_ctx = ld_param(lds, 5);
    q.w_mod = ld_param(lds, 6); q.b_mod = ld_param(lds, 7); q.norm_mix = ld_param(lds, 8); q.norm_mlp = ld_param(lds, 9); q.w_in = ld_param(lds, 10); q.lam_q1 = ld_param(lds, 11);
    q.lam_k1 = ld_param(lds, 12); q.lam_q2 = ld_param(lds, 13); q.lam_k2 = ld_param(lds, 14); q.subln = ld_param(lds, 15); q.conv_w = ld_param(lds, 16); q.conv_b = ld_param(lds, 17);
    q.w_s = ld_param(lds, 18); q.b_s = ld_param(lds, 19); q.w_out = ld_param(lds, 20); q.w_up = ld_param(lds, 21); q.w_down = ld_param(lds, 22); q.norm_final = ld_param(lds, 23);
    q.out = out; q.ws = ws; q.ph_lo = 0; q.ph_hi = 0; return q;
}
__device__ __forceinline__ void prologue_phase(const Params& p, LAS unsigned char* lds, int G, int bid, int tid, int wave, int lane) {
    unsigned char* ws = p.ws;
    LAS float* scr = (LAS float*)(lds + wave * 8704);
    LAS float* sc = (LAS float*)(lds + 69632);
    LAS float* red = (LAS float*)(lds + 69632 + 12288);
    float* mod = (float*)(ws + WS_MOD);
    for (int i = tid; i < 3072; i += 512) { const int s = i >> 10, k = i & 1023; const float v = s == 0 ? p.c_ctx[k] : p.c[(s - 1) * 1024 + k]; sc[i] = v / (1.f + __expf(-v)); }
    __syncthreads();
    for (int item = bid; item < 192; item += G) {
        const int d = item / 48, cgp = item % 48; const float* W = p.w_mod + (size_t)d * 1024 * 6144 + cgp * 128 + 2 * lane;
        float a00 = 0.f, a01 = 0.f, a10 = 0.f, a11 = 0.f, a20 = 0.f, a21 = 0.f; const int k0 = wave * 128;
#pragma unroll 16
        for (int kk = 0; kk < 128; ++kk) { const int k = k0 + kk; const float2 w = *(const float2*)(W + (size_t)k * 6144); const float s0 = sc[k], s1 = sc[1024 + k], s2 = sc[2048 + k];
            a00 += s0 * w.x; a01 += s0 * w.y; a10 += s1 * w.x; a11 += s1 * w.y; a20 += s2 * w.x; a21 += s2 * w.y; }
        red[(wave * 3 + 0) * 128 + 2 * lane] = a00; red[(wave * 3 + 0) * 128 + 2 * lane + 1] = a01;
        red[(wave * 3 + 1) * 128 + 2 * lane] = a10; red[(wave * 3 + 1) * 128 + 2 * lane + 1] = a11;
        red[(wave * 3 + 2) * 128 + 2 * lane] = a20; red[(wave * 3 + 2) * 128 + 2 * lane + 1] = a21;
        __syncthreads();
        if (tid < 384) { const int s = tid >> 7, col = tid & 127; float sum = p.b_mod[d * 6144 + cgp * 128 + col];
#pragma unroll
            for (int w = 0; w < 8; ++w) sum += red[(w * 3 + s) * 128 + col];
            mod[(d * 3 + s) * 6144 + cgp * 128 + col] = sum; }
        __syncthreads();
    }
    { const int gt = bid * 512 + tid; if (gt < 1024) { const int pos = gt >> 4, i = gt & 15; const float inv = exp2f(-(float)i * (13.287712379549449f / 16.f)); const float ang = (float)pos * inv;
        float* rc = (float*)(ws + WS_ROPE); rc[gt] = cosf(ang); rc[1024 + gt] = sinf(ang); } }
    const int vw = wave * G + bid, NVW = 8 * G;
    constexpr int I_IN = 16 * 88, I_OUT = 16 * 32, I_UP = 16 * 128, I_DN = 64 * 32, I_L = I_IN + I_OUT + I_UP + I_DN, I_CV = 8 * 16, I_ALL = 4 * I_L + 8 * I_CV;
    for (int it = vw; it < I_ALL; it += NVW) {
        if (it < 4 * I_L) { const int d = it / I_L; int r = it % I_L;
            if (r < I_IN) { transpose_item(p.w_in + (size_t)d * WIN_L, INW, (bf16_t*)(ws + WS_WIN) + (size_t)d * WIN_L, DM, scr, r, lane); continue; } r -= I_IN;
            if (r < I_OUT) { transpose_item(p.w_out + (size_t)d * WOUT_L, DM, (bf16_t*)(ws + WS_WOUT) + (size_t)d * WOUT_L, DM, scr, r, lane); continue; } r -= I_OUT;
            if (r < I_UP) { transpose_item(p.w_up + (size_t)d * WUP_L, DFF, (bf16_t*)(ws + WS_WUP) + (size_t)d * WUP_L, DM, scr, r, lane); continue; } r -= I_UP;
            transpose_item(p.w_down + (size_t)d * WDN_L, DM, (bf16_t*)(ws + WS_WDN) + (size_t)d * WDN_L, DFF, scr, r, lane);
        } else { const int r = it - 4 * I_L, bd = r / I_CV, b = bd >> 2, d = bd & 3;
            transpose_item(p.cache_v + (size_t)bd * 512 * 512, 512, (bf16_t*)(ws + WS_VTL) + (size_t)d * VTL_L + (size_t)b * 512 * 1536, 1536, scr, r % I_CV, lane); }
    }
    for (int i = bid * 512 + tid; i < 2 * 4 * 512 * 64; i += G * 512) { const int c8 = (i & 63) * 8, key = (i >> 6) & 511, bd = i >> 15, b = bd >> 2, d = bd & 3;
        const float* src = p.cache_k + ((size_t)bd * 512 + key) * 512 + c8; const f32x4 v0 = *(const f32x4*)src, v1 = *(const f32x4*)(src + 4);
        u32x4 o; o.x = cvtpk(v0[0], v0[1]); o.y = cvtpk(v0[2], v0[3]); o.z = cvtpk(v1[0], v1[1]); o.w = cvtpk(v1[2], v1[3]);
        *(u32x4*)((bf16_t*)(ws + WS_KL) + (size_t)d * KL_L + ((size_t)b * 1536 + key) * 512 + c8) = o; }
}

__device__ __forceinline__ void norm_phase(const Params& p, int layer, int which, int G, int bid, int wave, int lane) {
    const float* mod = (const float*)(p.ws + WS_MOD); const float* xbuf = p.out; bf16_t* H = (bf16_t*)(p.ws + WS_H);
    const float* g = (which ? p.norm_mlp : p.norm_mix) + layer * 1024;
    const bool first = (layer == 0 && which == 0);
    for (int row = wave * G + bid; row < NTOK; row += 8 * G) {
        const float* xr = first ? (row < NCTX ? p.x_prompt + (size_t)row * 1024 : p.x_sample + (size_t)(row - NCTX) * 1024) : xbuf + (size_t)row * 1024;
        const int s = row < NCTX ? 0 : 1 + ((row - NCTX) >> 10);
        const float* sh = mod + (size_t)((layer * 3 + s) * 6 + (which ? 3 : 0)) * 1024; const float* scl = sh + 1024;
        f32x4 v[4]; float ss = 0.f;
#pragma unroll
        for (int j = 0; j < 4; ++j) { v[j] = *(const f32x4*)(xr + 4 * lane + 256 * j); ss += (v[j][0] * v[j][0] + v[j][1] * v[j][1]) + (v[j][2] * v[j][2] + v[j][3] * v[j][3]); }
        const float rstd = rsqrtf(wave_sum(ss) * (1.f / 1024.f) + 1e-6f);
#pragma unroll
        for (int j = 0; j < 4; ++j) { const int c = 4 * lane + 256 * j; const f32x4 gg = *(const f32x4*)(g + c), a = *(const f32x4*)(scl + c), b = *(const f32x4*)(sh + c);
            const f32x4 y = v[j] * rstd * gg * (a + 1.f) + b; u32x2 w; w.x = cvtpk(y[0], y[1]); w.y = cvtpk(y[2], y[3]); *(u32x2*)(H + (size_t)row * 1024 + c) = w; }
    }
}
__device__ __forceinline__ void final_norm_phase(const Params& p, int G, int bid, int wave, int lane) {
    for (int row = wave * G + bid; row < NTOK; row += 8 * G) {
        float* xr = p.out + (size_t)row * 1024; f32x4 v[4]; float ss = 0.f;
#pragma unroll
        for (int j = 0; j < 4; ++j) { v[j] = *(const f32x4*)(xr + 4 * lane + 256 * j); ss += (v[j][0] * v[j][0] + v[j][1] * v[j][1]) + (v[j][2] * v[j][2] + v[j][3] * v[j][3]); }
        const float rstd = rsqrtf(wave_sum(ss) * (1.f / 1024.f) + 1e-6f);
#pragma unroll
        for (int j = 0; j < 4; ++j) { const int c = 4 * lane + 256 * j; *(f32x4*)(xr + c) = v[j] * rstd * *(const f32x4*)(p.norm_final + c); }
    }
}

struct AttnState { f32x16 O0[4], O1[4]; float m0, m1, l0, l1; };
__device__ __forceinline__ void sm_step(f32x16& S, float& m, float& l, f32x16 (&O)[4], bf16x8 (&P)[2]) {
    float mx = fmaxf(S[0], S[1]);
#pragma unroll
    for (int r = 2; r < 16; ++r) mx = fmaxf(mx, S[r]);
    mx = xhalf_max(mx);
    const float mn = fmaxf(m, mx);
    if (__any(mn > m)) { const float al = __builtin_amdgcn_exp2f(m - mn); l *= al;
#pragma unroll
        for (int b = 0; b < 4; ++b)
#pragma unroll
            for (int r = 0; r < 16; ++r) O[b][r] *= al; }
    m = mn; float ps = 0.f;
#pragma unroll
    for (int r = 0; r < 16; ++r) { S[r] = __builtin_amdgcn_exp2f(S[r] - mn); ps += S[r]; }
    l += ps;
#pragma unroll
    for (int s = 0; s < 2; ++s) { u32x4 w; w.x = cvtpk(S[8 * s], S[8 * s + 1]); w.y = cvtpk(S[8 * s + 2], S[8 * s + 3]); w.z = cvtpk(S[8 * s + 4], S[8 * s + 5]); w.w = cvtpk(S[8 * s + 6], S[8 * s + 7]); P[s] = __builtin_bit_cast(bf16x8, w); }
}
__device__ __forceinline__ void attn_tiles(AttnState& st, const bf16_t* Q, int qpitch, const bf16_t* K, int kpitch, const bf16_t* Vt, int vpitch, int ntiles, LAS unsigned char* qlds, int lane) {
    const int r32 = lane & 31, hi = lane >> 5;
    LAS bf16x8* qs = (LAS bf16x8*)qlds + lane;
#pragma unroll
    for (int c = 0; c < 2; ++c)
#pragma unroll
        for (int d0 = 0; d0 < 4; ++d0) qs[(c * 4 + d0) * 64] = *(const bf16x8*)(Q + (size_t)r32 * qpitch + c * 64 + d0 * 16 + hi * 8);
#pragma unroll
    for (int b = 0; b < 4; ++b) { st.O0[b] = f32x16{}; st.O1[b] = f32x16{}; }
    st.m0 = -1e30f; st.m1 = -1e30f; st.l0 = 0.f; st.l1 = 0.f;
    const int pr = (r32 & ~12) | ((r32 & 4) << 1) | ((r32 & 8) >> 1);
    const bf16_t* kp = K + (size_t)pr * kpitch + hi * 8; const bf16_t* vp = Vt + (size_t)r32 * vpitch + hi * 8;
    for (int t = 0; t < ntiles; ++t) {
        bf16x8 P0[2], P1[2];
        { bf16x8 kf[4];
#pragma unroll
          for (int d0 = 0; d0 < 4; ++d0) kf[d0] = *(const bf16x8*)(kp + d0 * 16);
          f32x16 S = f32x16{};
#pragma unroll
          for (int d0 = 0; d0 < 4; ++d0) S = __builtin_amdgcn_mfma_f32_32x32x16_bf16(kf[d0], qs[d0 * 64], S, 0, 0, 0);
          sm_step(S, st.m0, st.l0, st.O0, P0); }
        { bf16x8 kf[4];
#pragma unroll
          for (int d0 = 0; d0 < 4; ++d0) kf[d0] = *(const bf16x8*)(kp + 64 + d0 * 16);
          f32x16 S = f32x16{};
#pragma unroll
          for (int d0 = 0; d0 < 4; ++d0) S = __builtin_amdgcn_mfma_f32_32x32x16_bf16(kf[d0], qs[(4 + d0) * 64], S, 0, 0, 0);
          sm_step(S, st.m1, st.l1, st.O1, P1); }
#pragma unroll
        for (int s = 0; s < 2; ++s)
#pragma unroll
            for (int b = 0; b < 4; ++b) { const bf16x8 vf = *(const bf16x8*)(vp + (size_t)(b * 32) * vpitch + s * 16);
                st.O0[b] = __builtin_amdgcn_mfma_f32_32x32x16_bf16(vf, P0[s], st.O0[b], 0, 0, 0);
                st.O1[b] = __builtin_amdgcn_mfma_f32_32x32x16_bf16(vf, P1[s], st.O1[b], 0, 0, 0); }
        kp += (size_t)32 * kpitch; vp += 32;
    }
}
__device__ __forceinline__ void attn_finish_single(AttnState& st, float lam, const float* subln, float oscale, bf16_t* out, int lane) {
    const int r32 = lane & 31, hi = lane >> 5;
    const float i0 = 1.f / xhalf_sum(st.l0), i1 = lam / xhalf_sum(st.l1); float ss = 0.f;
#pragma unroll
    for (int b = 0; b < 4; ++b)
#pragma unroll
        for (int r = 0; r < 16; ++r) { const float R = st.O0[b][r] * i0 - st.O1[b][r] * i1; st.O0[b][r] = R; ss += R * R; }
    const float rstd = rsqrtf(xhalf_sum(ss) * (1.f / 128.f) + 1e-6f) * oscale;
#pragma unroll
    for (int b = 0; b < 4; ++b)
#pragma unroll
        for (int g = 0; g < 4; ++g) { const int dv = 32 * b + 8 * g + 4 * hi; const f32x4 sg = *(const f32x4*)(subln + dv);
            u32x2 w; w.x = cvtpk(st.O0[b][4 * g] * rstd * sg[0], st.O0[b][4 * g + 1] * rstd * sg[1]); w.y = cvtpk(st.O0[b][4 * g + 2] * rstd * sg[2], st.O0[b][4 * g + 3] * rstd * sg[3]);
            *(u32x2*)(out + (size_t)r32 * 1024 + dv) = w; }
}
__device__ __forceinline__ void attn_finish_split(AttnState& st, float lam, const float* subln, float oscale, bf16_t* out, LAS unsigned char* lds, int wave, int lane) {
    const int r32 = lane & 31, hi = lane >> 5;
    LAS float* red = (LAS float*)lds;
    LAS float* stt = (LAS float*)(lds + 131072);
    LAS float* ssq = stt + 1024;
    const float l0 = xhalf_sum(st.l0), l1 = xhalf_sum(st.l1);
    if (hi == 0) { stt[(wave * 4 + 0) * 32 + r32] = st.m0; stt[(wave * 4 + 1) * 32 + r32] = l0; stt[(wave * 4 + 2) * 32 + r32] = st.m1; stt[(wave * 4 + 3) * 32 + r32] = l1; }
    __syncthreads();
    float M0 = -1e30f, M1 = -1e30f;
#pragma unroll
    for (int w = 0; w < 8; ++w) { M0 = fmaxf(M0, stt[(w * 4 + 0) * 32 + r32]); M1 = fmaxf(M1, stt[(w * 4 + 2) * 32 + r32]); }
    float L0 = 0.f, L1 = 0.f;
#pragma unroll
    for (int w = 0; w < 8; ++w) { L0 += stt[(w * 4 + 1) * 32 + r32] * __builtin_amdgcn_exp2f(stt[(w * 4 + 0) * 32 + r32] - M0); L1 += stt[(w * 4 + 3) * 32 + r32] * __builtin_amdgcn_exp2f(stt[(w * 4 + 2) * 32 + r32] - M1); }
    const float f0 = __builtin_amdgcn_exp2f(st.m0 - M0) / L0, f1 = lam * __builtin_amdgcn_exp2f(st.m1 - M1) / L1;
#pragma unroll
    for (int b = 0; b < 4; ++b)
#pragma unroll
        for (int r = 0; r < 16; ++r) { red[(wave * 64 + b * 16 + r) * 64 + lane] = st.O0[b][r] * f0 - st.O1[b][r] * f1; if ((r & 3) == 3) asm volatile("" ::: "memory"); }
    __syncthreads();
    float R[8]; float ss = 0.f;
#pragma unroll
    for (int j = 0; j < 8; ++j) { float sum = 0.f;
#pragma unroll
        for (int w = 0; w < 8; ++w) sum += red[(w * 64 + wave * 8 + j) * 64 + lane];
        R[j] = sum; ss += sum * sum; }
    ss = xhalf_sum(ss);
    if (hi == 0) ssq[wave * 32 + r32] = ss;
    __syncthreads();
    float tot = 0.f;
#pragma unroll
    for (int w = 0; w < 8; ++w) tot += ssq[w * 32 + r32];
    const float rstd = rsqrtf(tot * (1.f / 128.f) + 1e-6f) * oscale;
#pragma unroll
    for (int g = 0; g < 2; ++g) { const int dv = 32 * (wave >> 1) + 16 * (wave & 1) + 8 * g + 4 * hi; const f32x4 sg = *(const f32x4*)(subln + dv);
        u32x2 w; w.x = cvtpk(R[4 * g] * rstd * sg[0], R[4 * g + 1] * rstd * sg[1]); w.y = cvtpk(R[4 * g + 2] * rstd * sg[2], R[4 * g + 3] * rstd * sg[3]);
        *(u32x2*)(out + (size_t)r32 * 1024 + dv) = w; }
    __syncthreads();
}

__device__ __forceinline__ void mixer_phase(const Params& p, int layer, LAS unsigned char* lds, int G, int bid, int wave, int lane) {
    unsigned char* ws = p.ws;
    const bf16_t* P = (const bf16_t*)(ws + WS_P); bf16_t* MIX = (bf16_t*)(ws + WS_MIX);
    const bf16_t* KL = (const bf16_t*)(ws + WS_KL) + (size_t)layer * KL_L; const bf16_t* VtL = (const bf16_t*)(ws + WS_VTL) + (size_t)layer * VTL_L;
    const bf16_t* VtC = (const bf16_t*)(ws + WS_VTC); const bf16_t* VsT = (const bf16_t*)(ws + WS_VST);
    const float lam_init = 0.8f - 0.6f * __expf(-0.3f * (float)layer);
    const float s1 = wave_sum(p.lam_q1[layer * 64 + lane] * p.lam_k1[layer * 64 + lane]), s2 = wave_sum(p.lam_q2[layer * 64 + lane] * p.lam_k2[layer * 64 + lane]);
    const float lam = __expf(s1) - __expf(s2) + lam_init; const float oscale = 1.f - lam_init;
    const float* subln = p.subln + layer * 128;
    for (int it = bid; it < 256; it += G) {
        const int b = it >> 7, h = (it >> 5) & 3, qt = it & 31; const int tok0 = NCTX + b * 1024 + qt * 32;
        AttnState st;
        attn_tiles(st, P + (size_t)tok0 * INW + h * 128, INW, KL + ((size_t)b * 1536 + 192 * wave) * 512 + h * 128, 512, VtL + (size_t)((b * 4 + h) * 128) * 1536 + 192 * wave, 1536, 6, lds + wave * 8192, lane);
        attn_finish_split(st, lam, subln, oscale, MIX + (size_t)tok0 * 1024 + h * 128, lds, wave, lane);
    }
    if (wave < 4) {
        for (int it = wave * G + bid; it < 1024; it += 4 * G) {
            const int b = it >> 5, h = (it >> 3) & 3, qt = it & 7; const int tok0 = b * 256 + qt * 32;
            AttnState st;
            attn_tiles(st, P + (size_t)tok0 * INW + h * 128, INW, P + (size_t)(b * 256) * INW + 512 + h * 128, INW, VtC + (size_t)((b * 4 + h) * 128) * 256, 256, 8, lds + wave * 8192, lane);
            attn_finish_single(st, lam, subln, oscale, MIX + (size_t)tok0 * 1024 + h * 128, lane);
        }
    } else {
        const float* cw = p.conv_w + layer * 768; const float* cb = p.conv_b + layer * 256;
        for (int i = ((wave - 4) * G + bid) * 64 + lane; i < NTOK * 32; i += 4 * G * 64) {
            const int tok = i >> 5, c8 = (i & 31) * 8; const bf16_t* row = P + (size_t)tok * INW; const int sl = tok < NCTX ? 256 : 1024, pos = tok & (sl - 1);
            const u32x4 gb = *(const u32x4*)(row + 1536 + c8), gc1 = *(const u32x4*)(row + 1792 + c8), xi1 = *(const u32x4*)(row + 2048 + c8);
            u32x4 gc0 = {0u, 0u, 0u, 0u}, xi0 = gc0, gc2 = gc0, xi2 = gc0;
            if (pos > 0) { gc0 = *(const u32x4*)(row - INW + 1792 + c8); xi0 = *(const u32x4*)(row - INW + 2048 + c8); }
            if (pos < sl - 1) { gc2 = *(const u32x4*)(row + INW + 1792 + c8); xi2 = *(const u32x4*)(row + INW + 2048 + c8); }
            u32x4 o;
#pragma unroll
            for (int e = 0; e < 4; ++e) { float r2[2];
#pragma unroll
                for (int hh = 0; hh < 2; ++hh) { const int sh = hh * 16; const int ch = c8 + 2 * e + hh;
#define ex(w) __uint_as_float(((w) >> sh) << 16)
                    const float g0 = ex(gc0[e]) * ex(xi0[e]), g1 = ex(gc1[e]) * ex(xi1[e]), g2 = ex(gc2[e]) * ex(xi2[e]);
                    r2[hh] = ex(gb[e]) * (g0 * cw[ch] + g1 * cw[256 + ch] + g2 * cw[512 + ch] + cb[ch]); }
#undef ex
                o[e] = cvtpk(r2[0], r2[1]); }
            *(u32x4*)(MIX + (size_t)tok * 1024 + 512 + c8) = o;
        }
        const float* wsl = p.w_s + (size_t)layer * 4 * 128 * 128; const float* bsl = p.b_s + layer * 512;
        const int r32 = lane & 31, hi = lane >> 5;
        for (int it = (wave - 4) * G + bid; it < 80 * 32; it += 4 * G) {
            const int ch = it >> 5, g = (it >> 3) & 3, db = (it >> 2) & 1, pb = it & 3;
            const bf16_t* ap = VsT + (size_t)(g * 64 + db * 32 + r32) * NTOK + ch * 128 + hi * 8;
            const float* bp = wsl + (size_t)(g * 128 + pb * 32 + r32) * 128 + hi * 8;
            f32x16 D = f32x16{};
#pragma unroll
            for (int ks = 0; ks < 8; ++ks) { const bf16x8 a = *(const bf16x8*)(ap + ks * 16); const f32x4 b0 = *(const f32x4*)(bp + ks * 16), b1 = *(const f32x4*)(bp + ks * 16 + 4);
                u32x4 w; w.x = cvtpk(b0[0], b0[1]); w.y = cvtpk(b0[2], b0[3]); w.z = cvtpk(b1[0], b1[1]); w.w = cvtpk(b1[2], b1[3]);
                D = __builtin_amdgcn_mfma_f32_32x32x16_bf16(a, __builtin_bit_cast(bf16x8, w), D, 0, 0, 0); }
            const int tok = ch * 128 + pb * 32 + r32; const float bias = bsl[g * 128 + pb * 32 + r32];
#pragma unroll
            for (int q4 = 0; q4 < 4; ++q4) { const int d = g * 64 + db * 32 + 8 * q4 + 4 * hi; const u32x2 uu = *(const u32x2*)(P + (size_t)tok * INW + 2304 + d);
                u32x2 w; w.x = cvtpk(__uint_as_float(uu.x << 16) * (D[4 * q4] + bias), __uint_as_float(uu.x & 0xffff0000u) * (D[4 * q4 + 1] + bias));
                w.y = cvtpk(__uint_as_float(uu.y << 16) * (D[4 * q4 + 2] + bias), __uint_as_float(uu.y & 0xffff0000u) * (D[4 * q4 + 3] + bias));
                *(u32x2*)(MIX + (size_t)tok * 1024 + 768 + d) = w; }
        }
    }
}

__global__ void __launch_bounds__(512, 2) mega(Params p) {
    extern __shared__ __attribute__((aligned(16))) unsigned char lds_raw[];
    LAS unsigned char* lds = (LAS unsigned char*)lds_raw;
    const int wave = __builtin_amdgcn_readfirstlane(threadIdx.x >> 6), G = gridDim.x, bid = blockIdx.x;
    unsigned char* ws = p.ws; float* outp = p.out;
    const int lo = (int)p.ph_lo, hi = (int)p.ph_hi; int ph = 0;
    if (threadIdx.x == 0) { LAS unsigned long long* st = (LAS unsigned long long*)(lds + STASH_OFF);
        st[0] = (unsigned long long)p.x_prompt; st[1] = (unsigned long long)p.x_sample; st[2] = (unsigned long long)p.cache_k; st[3] = (unsigned long long)p.cache_v; st[4] = (unsigned long long)p.c; st[5] = (unsigned long long)p.c_ctx;
        st[6] = (unsigned long long)p.w_mod; st[7] = (unsigned long long)p.b_mod; st[8] = (unsigned long long)p.norm_mix; st[9] = (unsigned long long)p.norm_mlp; st[10] = (unsigned long long)p.w_in; st[11] = (unsigned long long)p.lam_q1;
        st[12] = (unsigned long long)p.lam_k1; st[13] = (unsigned long long)p.lam_q2; st[14] = (unsigned long long)p.lam_k2; st[15] = (unsigned long long)p.subln; st[16] = (unsigned long long)p.conv_w; st[17] = (unsigned long long)p.conv_b;
        st[18] = (unsigned long long)p.w_s; st[19] = (unsigned long long)p.b_s; st[20] = (unsigned long long)p.w_out; st[21] = (unsigned long long)p.w_up; st[22] = (unsigned long long)p.w_down; st[23] = (unsigned long long)p.norm_final; }
    __syncthreads();
#define PH_IN() (lo <= ph && ph < hi)
#define LAUNDER() int lane2; asm volatile("v_mbcnt_lo_u32_b32 %0, -1, 0\n\tv_mbcnt_hi_u32_b32 %0, -1, %0" : "=v"(lane2)); const int wave2 = wave, tid2 = wave * 64 + lane2
#define PH_END() do { if (lo <= ph && ph + 1 < hi) cg::this_grid().sync(); ++ph; } while (0)
    if (PH_IN()) { LAUNDER(); const Params q = load_params(lds, ws, outp); prologue_phase(q, lds, G, bid, tid2, wave2, lane2); }
    PH_END();
    if (PH_IN()) { LAUNDER(); const Params q = load_params(lds, ws, outp); norm_phase(q, 0, 0, G, bid, wave2, lane2); }
    PH_END();
    const float* mod = (const float*)(ws + WS_MOD);
    for (int L = 0; L < NLAYER; ++L) {
        if (PH_IN()) {
            pg8::Gemm g{(const bf16_t*)(ws + WS_H), (const bf16_t*)(ws + WS_WIN) + (size_t)L * WIN_L, NTOK, INW, DM}; pg8::StaticOrder S; S.init(NTOK, INW, G, bid);
            pg8::EpiIn E{ws, outp, L};
            pg8::gemm_phase<pg8::EpiIn, pg8::StaticOrder, true, true>(lds, g, S, E, wave);
        }
        PH_END();
        if (PH_IN()) { LAUNDER(); const Params q = load_params(lds, ws, outp); mixer_phase(q, L, lds, G, bid, wave2, lane2); }
        PH_END();
        if (PH_IN()) {
            pg8::Gemm g{(const bf16_t*)(ws + WS_MIX), (const bf16_t*)(ws + WS_WOUT) + (size_t)L * WOUT_L, NTOK, DM, DM}; pg8::StaticOrder S; S.init(NTOK, DM, G, bid);
            pg8::EpiRes E{ld_param(lds, 0), ld_param(lds, 1), outp, mod + (size_t)(L * 3) * 6144 + 2 * 1024, L == 0 ? 1 : 0};
            pg8::gemm_phase<pg8::EpiRes, pg8::StaticOrder, true, true>(lds, g, S, E, wave);
        }
        PH_END();
        if (PH_IN()) { LAUNDER(); const Params q = load_params(lds, ws, outp); norm_phase(q, L, 1, G, bid, wave2, lane2); }
        PH_END();
        if (PH_IN()) {
            pg8::Gemm g{(const bf16_t*)(ws + WS_H), (const bf16_t*)(ws + WS_WUP) + (size_t)L * WUP_L, NTOK, DFF, DM}; pg8::StaticOrder S; S.init(NTOK, DFF, G, bid);
            pg8::EpiUp E{(bf16_t*)(ws + WS_A), DFF};
            pg8::gemm_phase<pg8::EpiUp, pg8::StaticOrder, true, true>(lds, g, S, E, wave);
        }
        PH_END();
        if (PH_IN()) {
            pg8::Gemm g{(const bf16_t*)(ws + WS_A), (const bf16_t*)(ws + WS_WDN) + (size_t)L * WDN_L, NTOK, DM, DFF}; pg8::StaticOrder S; S.init(NTOK, DM, G, bid);
            pg8::EpiRes E{outp, outp, outp, mod + (size_t)(L * 3) * 6144 + 5 * 1024, 0};
            pg8::gemm_phase<pg8::EpiRes, pg8::StaticOrder, true, true>(lds, g, S, E, wave);
        }
        PH_END();
        if (PH_IN()) { LAUNDER(); const Params q = load_params(lds, ws, outp); if (L + 1 < NLAYER) norm_phase(q, L + 1, 0, G, bid, wave2, lane2); else final_norm_phase(q, G, bid, wave2, lane2); }
        PH_END();
    }
}
constexpr int N_PHASES = 2 + 7 * NLAYER;

extern "C" void kernel_launch(void* const* d_in, const int* in_sizes, int n_in, void* d_out, int out_size, void* d_ws, size_t ws_size, hipStream_t stream) {
    static int grid = 0;
    if (grid == 0) {
        if (n_in != 24 || ws_size < WS_END) { fprintf(stderr, "kernel_launch: unexpected n_in %d / ws_size %zu\n", n_in, ws_size); grid = -1; return; }
        int dev = 0, cus = 0, per_cu = 0;
        (void)hipGetDevice(&dev); (void)hipDeviceGetAttribute(&cus, hipDeviceAttributeMultiprocessorCount, dev);
        if (hipFuncSetAttribute((const void*)mega, hipFuncAttributeMaxDynamicSharedMemorySize, LDS_BYTES) != hipSuccess) { fprintf(stderr, "kernel_launch: hipFuncSetAttribute failed\n"); }
        if (hipOccupancyMaxActiveBlocksPerMultiprocessor(&per_cu, (const void*)mega, 512, LDS_BYTES) != hipSuccess || per_cu < 1) { fprintf(stderr, "kernel_launch: occupancy query gave %d\n", per_cu); per_cu = 1; }
        (void)hipGetLastError();
        grid = cus * per_cu;
        if (grid <= 0) grid = 256;
    }
    if (grid < 0) return;
    Params p{};
    const float** dst = (const float**)&p;
    for (int i = 0; i < 24; ++i) dst[i] = (const float*)d_in[i];
    p.out = (float*)d_out; p.ws = (unsigned char*)d_ws;
#if MULTI_LAUNCH
    for (int ph = 0; ph < N_PHASES; ++ph) { p.ph_lo = ph; p.ph_hi = ph + 1; hipLaunchKernelGGL(mega, dim3(grid), dim3(512), LDS_BYTES, stream, p); }
#else
    p.ph_lo = 0; p.ph_hi = N_PHASES;
    void* args[] = {&p};
    hipError_t e = hipLaunchCooperativeKernel((const void*)mega, dim3(grid), dim3(512), args, LDS_BYTES, stream);
    if (e != hipSuccess) fprintf(stderr, "kernel_launch: cooperative launch failed: %s (grid %d)\n", hipGetErrorString(e), grid);
#endif
}
```

```cpp
#include <hip/hip_runtime.h>
#include <hip/hip_cooperative_groups.h>
#include <cstdio>
#include <cstdint>
namespace cg = cooperative_groups;
#ifndef REP_PRO
#define REP_PRO 1
#endif
#ifndef REP_MIX
#define REP_MIX 1
#endif
#ifndef REP_GIN
#define REP_GIN 1
#endif
#ifndef REP_GUP
#define REP_GUP 1
#endif
#ifndef MULTI_LAUNCH
#define MULTI_LAUNCH 0
#endif
namespace pg8 {
#define PG8_LAS __attribute__((address_space(3)))
typedef unsigned short bf16_t;
typedef short bf16x8 __attribute__((ext_vector_type(8)));
typedef float f32x4 __attribute__((ext_vector_type(4)));
typedef unsigned u32x4 __attribute__((ext_vector_type(4)));
constexpr int BM = 256, BK = 64, HALF = 128, HTB = HALF * BK * 2  , STAGE_BYTES = 8 * HTB, NXCD = 8, WGM = 8;

__host__ __device__ __forceinline__ int lds_byte(int r, int c) { const int st = (r >> 4) * 2 + (c >> 5), rr = r & 15, cc = c & 31, ob = rr * 64 + cc * 2; return st * 1024 + (ob ^ (((ob >> 9) & 1) << 5)); }
__host__ __device__ __forceinline__ void stage_rc(int b, int& R, int& C) { const int st = b / 1024, sb = b % 1024, swz = sb ^ (((sb >> 9) & 1) << 5); R = (st >> 1) * 16 + swz / 64; C = (st & 1) * 32 + (swz % 64) / 2; }
__host__ __device__ __forceinline__ int perm32(int rho) { const int n = rho >> 4, i = rho & 15; return 8 * (i >> 2) + 4 * n + (i & 3); }

struct Unit { int pm, pn; };
struct Gemm { const bf16_t* A; const bf16_t* Bt; int M, N, K; };

struct StaticOrder {
    int nM, nN, nwg, G, c;
    __host__ __device__ void init(int M, int N, int G_, int c_) { nM = M / BM; nN = N / BM; nwg = nM * nN; G = G_; c = c_; }
    __host__ __device__ bool next(int i, Unit& u) const {
        const long L = (long)i * G + c; if (L >= nwg) return false;
        int wgid = (int)L; { const int q = nwg / NXCD, r = nwg % NXCD, xcd = wgid % NXCD, off = wgid / NXCD; wgid = (xcd < r ? xcd * (q + 1) : r * (q + 1) + (xcd - r) * q) + off; }
        const int nig = WGM * nN, gid = wgid / nig, fm = gid * WGM, gsz = (nM - fm) < WGM ? (nM - fm) : WGM;
        u.pm = fm + ((wgid % nig) % gsz); u.pn = (wgid % nig) / gsz; return true;
    }
    __device__ __forceinline__ void a_ready(const Unit&) const {}
    __device__ __forceinline__ void done(const Unit&) const {}
};

__device__ __forceinline__ unsigned cvt_pk_bf16(float lo, float hi) { unsigned r; asm volatile("v_cvt_pk_bf16_f32 %0, %1, %2" : "=v"(r) : "v"(lo), "v"(hi)); return r; }
typedef unsigned u32x2 __attribute__((ext_vector_type(2)));
typedef float f32x2_t __attribute__((ext_vector_type(2))); typedef __bf16 bf16x2_t __attribute__((ext_vector_type(2)));
__device__ __forceinline__ unsigned cvtpk(float lo, float hi) { f32x2_t v = {lo, hi}; bf16x2_t b = __builtin_convertvector(v, bf16x2_t); return __builtin_bit_cast(unsigned, b); }
constexpr float QSCALE = 0.125f * 1.4426950408889634f;

struct EpiIn {
    static constexpr bool PERM = false, AFTER_DRAIN = false;
    unsigned char* ws; float* out; int layer;
    static __device__ __forceinline__ bool swapped(const Unit& u) { return u.pn == 4 || u.pn == 5 || u.pn == 10; }
    __device__ __forceinline__ void operator()(const f32x4 (&acc)[2][2][4][2], const Unit& u, int wr, int wc, int fr, int fq) const {
        const int pn = u.pn, pm = u.pm;
        bf16_t* P = (bf16_t*)(ws + (176u << 20)); bf16_t* KL = (bf16_t*)(ws + (116u << 20)) + (size_t)layer * (2 * 1536 * 512); bf16_t* VtC = (bf16_t*)(ws + (140u << 20));
        bf16_t* VtL = (bf16_t*)(ws + (128u << 20)) + (size_t)layer * (2 * 512 * 1536); bf16_t* VsT = (bf16_t*)(ws + (148u << 20));
        float* ck = out + (size_t)10240 * 1024; float* cv = ck + (size_t)32 * 4 * 256 * 512; const float* rc = (const float*)(ws + (1u << 20) + 512 * 1024); const float* rs = rc + 1024;
        if (pn == 4 || pn == 5 || pn == 10) {
#pragma unroll
            for (int ai = 0; ai < 2; ++ai)
#pragma unroll
                for (int m = 0; m < 4; ++m) {
                    const int R = (pn == 10 ? 0 : (pn - 4) * 256) + ai * 128 + wr * 64 + m * 16 + fr;
#pragma unroll
                    for (int bj = 0; bj < 2; ++bj)
#pragma unroll
                        for (int n = 0; n < 2; ++n) {
                            const int tl = bj * 128 + wc * 32 + n * 16 + 4 * fq;
                            const f32x4 v = acc[ai][bj][m][n]; u32x2 w; w.x = cvtpk(v[0], v[1]); w.y = cvtpk(v[2], v[3]);
                            if (pn == 10) *(u32x2*)(VsT + (size_t)R * 10240 + pm * 256 + tl) = w;
                            else if (pm < 32) { *(u32x2*)(VtC + (size_t)(pm * 512 + R) * 256 + tl) = w;
                                float* o = cv + (size_t)((pm * 4 + layer) * 256 + tl) * 512 + R; o[0] = v[0]; o[512] = v[1]; o[1024] = v[2]; o[1536] = v[3]; }
                            else { const int b = (pm - 32) >> 2, t = ((pm - 32) & 3) * 256 + tl; *(u32x2*)(VtL + (size_t)(b * 512 + R) * 1536 + 512 + t) = w; }
                        }
                }
            return;
        }
        const int row0 = pm * 256 + wr * 64 + fr, colt = pn * 256 + wc * 32 + 4 * fq;
        if (pn < 4) {
            const bool isq = pn < 2; const float sc = isq ? QSCALE : 1.f;
            if (pm < 32) {
#pragma unroll
                for (int ai = 0; ai < 2; ++ai)
#pragma unroll
                    for (int m = 0; m < 4; ++m) { const int row = row0 + ai * 128 + m * 16;
#pragma unroll
                        for (int bj = 0; bj < 2; ++bj)
#pragma unroll
                            for (int n = 0; n < 2; ++n) { const int col = colt + bj * 128 + n * 16; const f32x4 a = acc[ai][bj][m][n]; const f32x4 v = a * sc;
                                u32x2 w; w.x = cvtpk(v[0], v[1]); w.y = cvtpk(v[2], v[3]); *(u32x2*)(P + (size_t)row * 2816 + col) = w;
                                if (!isq) *(f32x4*)(ck + (size_t)((pm * 4 + layer) * 256 + (row & 255)) * 512 + (col - 512)) = a; } }
            } else {
                const int b = (pm - 32) >> 2;
#pragma unroll
                for (int ai = 0; ai < 2; ++ai)
#pragma unroll
                    for (int m = 0; m < 4; ++m) { const int row = row0 + ai * 128 + m * 16; const int tpos = (row - 8192) & 1023; const int pos = (wc & 1) ? (tpos & 63) : (tpos >> 6);
                        const f32x4 cs = *(const f32x4*)(rc + pos * 16 + 4 * fq), sn = *(const f32x4*)(rs + pos * 16 + 4 * fq);
#pragma unroll
                        for (int bj = 0; bj < 2; ++bj) { const f32x4 x1 = acc[ai][bj][m][0], x2 = acc[ai][bj][m][1];
                            const f32x4 o1 = (x1 * cs - x2 * sn) * sc, o2 = (x2 * cs + x1 * sn) * sc; const int col = colt + bj * 128;
                            u32x2 w1, w2; w1.x = cvtpk(o1[0], o1[1]); w1.y = cvtpk(o1[2], o1[3]); w2.x = cvtpk(o2[0], o2[1]); w2.y = cvtpk(o2[2], o2[3]);
                            bf16_t* dst = isq ? (P + (size_t)row * 2816 + col) : (KL + (size_t)(b * 1536 + 512 + tpos) * 512 + (col - 512));
                            *(u32x2*)dst = w1; *(u32x2*)(dst + 16) = w2; } }
            }
        } else {
#pragma unroll
            for (int ai = 0; ai < 2; ++ai)
#pragma unroll
                for (int m = 0; m < 4; ++m) { const int row = row0 + ai * 128 + m * 16;
#pragma unroll
                    for (int bj = 0; bj < 2; ++bj)
#pragma unroll
                        for (int n = 0; n < 2; ++n) { const int col = colt + bj * 128 + n * 16; const f32x4 v = acc[ai][bj][m][n];
                            u32x2 w; w.x = cvtpk(v[0], v[1]); w.y = cvtpk(v[2], v[3]); *(u32x2*)(P + (size_t)row * 2816 + col) = w; } }
        }
    }
};
struct EpiRes {
    static constexpr bool PERM = false, AFTER_DRAIN = false;
    const float* xp; const float* xs; float* xbuf; const float* gate_base; int first;
    static __device__ __forceinline__ bool swapped(const Unit&) { return false; }
    __device__ __forceinline__ void operator()(const f32x4 (&acc)[2][2][4][2], const Unit& u, int wr, int wc, int fr, int fq) const {
        const int s = u.pm < 32 ? 0 : 1 + ((u.pm - 32) >> 2); const float* gate = gate_base + s * 6144;
        const int col0 = u.pn * 256 + wc * 32 + 4 * fq;
        f32x4 gv[2][2];
#pragma unroll
        for (int bj = 0; bj < 2; ++bj)
#pragma unroll
            for (int n = 0; n < 2; ++n) gv[bj][n] = *(const f32x4*)(gate + col0 + bj * 128 + n * 16);
#pragma unroll
        for (int ai = 0; ai < 2; ++ai)
#pragma unroll
            for (int m = 0; m < 4; ++m) { const int row = u.pm * 256 + ai * 128 + wr * 64 + m * 16 + fr;
                const float* src = first ? (row < 8192 ? xp + (size_t)row * 1024 : xs + (size_t)(row - 8192) * 1024) : xbuf + (size_t)row * 1024; float* dst = xbuf + (size_t)row * 1024;
#pragma unroll
                for (int bj = 0; bj < 2; ++bj)
#pragma unroll
                    for (int n = 0; n < 2; ++n) { const int c = col0 + bj * 128 + n * 16; *(f32x4*)(dst + c) = *(const f32x4*)(src + c) + gv[bj][n] * acc[ai][bj][m][n]; } }
    }
};
struct EpiUp {
    static constexpr bool PERM = true, AFTER_DRAIN = false;
    bf16_t* O; int ldc;
    static __device__ __forceinline__ bool swapped(const Unit&) { return false; }
    __device__ __forceinline__ void operator()(const f32x4 (&acc)[2][2][4][2], const Unit& u, int wr, int wc, int fr, int fq) const {
        const int row0 = u.pm * 256 + wr * 64 + fr, col0 = u.pn * 256 + wc * 32 + 8 * fq;
#pragma unroll
        for (int ai = 0; ai < 2; ++ai)
#pragma unroll
            for (int m = 0; m < 4; ++m) { bf16_t* rowp = O + (size_t)(row0 + ai * 128 + m * 16) * ldc + col0;
#pragma unroll
                for (int bj = 0; bj < 2; ++bj) { f32x4 v0 = acc[ai][bj][m][0], v1 = acc[ai][bj][m][1];
#pragma unroll
                    for (int e = 0; e < 4; ++e) { const float a = fmaxf(v0[e], 0.f), b = fmaxf(v1[e], 0.f); v0[e] = a * a; v1[e] = b * b; }
                    u32x4 w; w.x = cvtpk(v0[0], v0[1]); w.y = cvtpk(v0[2], v0[3]); w.z = cvtpk(v1[0], v1[1]); w.w = cvtpk(v1[2], v1[3]);
                    *(u32x4*)(rowp + bj * 128) = w; } }
    }
};
template <class Epi, class Sched, bool ALIGN_EPI = false, bool SP2 = false>
__device__ __forceinline__ void gemm_phase(PG8_LAS unsigned char* lds, const Gemm g, const Sched& S, const Epi& E, int wave_s) {
    int tid_l; asm volatile("v_mbcnt_lo_u32_b32 %0, -1, 0\n\tv_mbcnt_hi_u32_b32 %0, -1, %0" : "=v"(tid_l)); tid_l += wave_s * 64;
    const int tid = tid_l, wid = __builtin_amdgcn_readfirstlane(tid >> 6), lane = tid & 63, wr = wid >> 2, wc = wid & 3, fr = lane & 15, fq = lane >> 4;
    const int K = g.K, nt = K / BK;
    unsigned voffA[2], voffB[2];
#pragma unroll
    for (int i = 0; i < 2; ++i) { int R, C; stage_rc(tid * 16 + i * 8192, R, C); const int Rb = Epi::PERM ? ((R & ~31) + perm32(R & 31)) : R;
        voffA[i] = (unsigned)(R * K + C) * 2u; voffB[i] = (unsigned)(Rb * K + C) * 2u; }
    const size_t kstep = (size_t)(BK * 2);
    const size_t hstep = (size_t)HALF * K * 2;
    const size_t tstep = 2 * hstep;
    const unsigned ldsw = (unsigned)wid * 1024u;
    const int aoff = lds_byte(wr * 64 + fr, fq * 8), boff = lds_byte(wc * 32 + fr, fq * 8);
#define PG8_SA(b, h) (((b) * 2 + (h)) * HTB)
#define PG8_SB(b, h) ((4 + (b) * 2 + (h)) * HTB)
#define PG8_STAGE(bufoff, gbase, voff) do { _Pragma("unroll") for (int _i = 0; _i < 2; ++_i) \
        __builtin_amdgcn_global_load_lds((const unsigned*)((const char*)(gbase) + (voff)[_i]), (PG8_LAS unsigned*)(lds + (bufoff) + ldsw + _i * 8192), 16, 0, 0); } while (0)
#define PG8_LDA(dst, b, h) do { _Pragma("unroll") for (int m = 0; m < 4; ++m) _Pragma("unroll") for (int k = 0; k < 2; ++k) dst[m][k] = *(const PG8_LAS bf16x8*)(lds + PG8_SA(b, h) + aoff + m * 2048 + k * 1024); } while (0)
#define PG8_LDB(dst, b, h) do { _Pragma("unroll") for (int n = 0; n < 2; ++n) _Pragma("unroll") for (int k = 0; k < 2; ++k) dst[n][k] = *(const PG8_LAS bf16x8*)(lds + PG8_SB(b, h) + boff + n * 2048 + k * 1024); } while (0)
#define PG8_MMA(ai, bj, At, Bt) do { __builtin_amdgcn_s_setprio(1); _Pragma("unroll") for (int m = 0; m < 4; ++m) _Pragma("unroll") for (int n = 0; n < 2; ++n) _Pragma("unroll") for (int k = 0; k < 2; ++k) \
        acc[ai][bj][m][n] = __builtin_amdgcn_mfma_f32_16x16x32_bf16(Bt[n][k], At[m][k], acc[ai][bj][m][n], 0, 0, 0); __builtin_amdgcn_s_setprio(0); } while (0)
#define PG8_WAIT_V(n) asm volatile("s_waitcnt vmcnt(" #n ")" ::: "memory")
#define PG8_WAIT_L(n) asm volatile("s_waitcnt lgkmcnt(" #n ")" ::: "memory")
#define PG8_BAR __builtin_amdgcn_s_barrier()
#define PG8_SCHED __builtin_amdgcn_sched_barrier(0)
    Unit cur, nxt; int ui = 0;
    if (!S.next(0, cur)) return;
    f32x4 acc[2][2][4][2];
#pragma unroll
    for (int a = 0; a < 2; ++a)
#pragma unroll
        for (int b = 0; b < 2; ++b)
#pragma unroll
            for (int m = 0; m < 4; ++m)
#pragma unroll
                for (int n = 0; n < 2; ++n) acc[a][b][m][n] = (f32x4){0.f, 0.f, 0.f, 0.f};
    bf16x8 At[4][2], B0[2][2], B1[2][2];
    const char* cA = (const char*)g.A + (size_t)cur.pm * tstep; const char* cB = (const char*)g.Bt + (size_t)cur.pn * tstep;
    if (Epi::swapped(cur)) { const char* t_ = cA; cA = cB; cB = t_; }
    S.a_ready(cur);
    if constexpr (SP2) {
        PG8_STAGE(PG8_SB(0, 0), cB, voffB); PG8_STAGE(PG8_SB(0, 1), cB + hstep, voffB); PG8_STAGE(PG8_SA(0, 0), cA, voffA); PG8_STAGE(PG8_SA(0, 1), cA + hstep, voffA);
        if (wr == 1) PG8_BAR;
        PG8_WAIT_V(2); PG8_BAR;
        PG8_STAGE(PG8_SB(1, 0), cB + kstep, voffB); PG8_STAGE(PG8_SA(1, 0), cA + kstep, voffA); PG8_STAGE(PG8_SB(1, 1), cB + hstep + kstep, voffB);
        PG8_WAIT_V(6); PG8_BAR;
    } else {
        PG8_STAGE(PG8_SB(0, 0), cB, voffB); PG8_STAGE(PG8_SA(0, 0), cA, voffA); PG8_STAGE(PG8_SB(0, 1), cB + hstep, voffB); PG8_STAGE(PG8_SA(0, 1), cA + hstep, voffA);
        if (wr == 1) PG8_BAR;
        PG8_WAIT_V(4); PG8_BAR;
        PG8_STAGE(PG8_SB(1, 0), cB + kstep, voffB); PG8_STAGE(PG8_SA(1, 0), cA + kstep, voffA); PG8_STAGE(PG8_SB(1, 1), cB + hstep + kstep, voffB);
        PG8_WAIT_V(6); PG8_BAR;
    }
    for (;;) {
        const bool has_next = S.next(ui + 1, nxt);
        const char* nA = has_next ? (const char*)g.A + (size_t)nxt.pm * tstep : cA; const char* nB = has_next ? (const char*)g.Bt + (size_t)nxt.pn * tstep : cB;
        if (has_next && Epi::swapped(nxt)) { const char* t_ = nA; nA = nB; nB = t_; }
        for (int t = 0; t < nt; t += 2) {
            const bool last = (t == nt - 2);
            const char* a1 = cA + (size_t)(t + 1) * kstep;
            const char* a2 = last ? nA : cA + (size_t)(t + 2) * kstep; const char* b2 = last ? nB : cB + (size_t)(t + 2) * kstep;
            const char* a3 = a2 + kstep; const char* b3 = b2 + kstep;
            if (last && has_next) S.a_ready(nxt);
            if constexpr (SP2) {
            PG8_LDB(B0, 0, 0); PG8_LDB(B1, 0, 1); PG8_SCHED; PG8_LDA(At, 0, 0); PG8_STAGE(PG8_SA(1, 1), a1 + hstep, voffA);
            PG8_WAIT_V(8); PG8_WAIT_L(0); PG8_BAR; PG8_MMA(0, 0, At, B0); PG8_MMA(0, 1, At, B1); PG8_BAR; PG8_SCHED;
            PG8_LDA(At, 0, 1); PG8_STAGE(PG8_SB(0, 0), b2, voffB); PG8_STAGE(PG8_SB(0, 1), b2 + hstep, voffB); PG8_STAGE(PG8_SA(0, 0), a2, voffA);
            PG8_WAIT_V(8); PG8_WAIT_L(0); PG8_BAR; PG8_MMA(1, 0, At, B0); PG8_MMA(1, 1, At, B1); PG8_BAR; PG8_SCHED;
            PG8_LDB(B0, 1, 0); PG8_LDB(B1, 1, 1); PG8_SCHED; PG8_LDA(At, 1, 0); PG8_STAGE(PG8_SA(0, 1), a2 + hstep, voffA);
            PG8_WAIT_V(8); PG8_WAIT_L(0); PG8_BAR; PG8_MMA(0, 0, At, B0); PG8_MMA(0, 1, At, B1); PG8_BAR; PG8_SCHED;
            PG8_LDA(At, 1, 1); PG8_STAGE(PG8_SB(1, 0), b3, voffB); PG8_STAGE(PG8_SB(1, 1), b3 + hstep, voffB); PG8_STAGE(PG8_SA(1, 0), a3, voffA);
            PG8_WAIT_V(8); PG8_WAIT_L(0); PG8_BAR; PG8_MMA(1, 0, At, B0); PG8_MMA(1, 1, At, B1); PG8_BAR; PG8_SCHED;
            } else {
            PG8_LDB(B0, 0, 0); PG8_SCHED; PG8_LDA(At, 0, 0); PG8_STAGE(PG8_SA(1, 1), a1 + hstep, voffA);
            PG8_WAIT_L(8); PG8_BAR; PG8_WAIT_L(0); PG8_MMA(0, 0, At, B0); PG8_BAR; PG8_SCHED;
            PG8_LDB(B1, 0, 1); PG8_STAGE(PG8_SB(0, 0), b2, voffB);
            PG8_BAR; PG8_WAIT_L(0); PG8_MMA(0, 1, At, B1); PG8_BAR;
            PG8_LDA(At, 0, 1); PG8_STAGE(PG8_SA(0, 0), a2, voffA);
            PG8_BAR; PG8_WAIT_L(0); PG8_MMA(1, 0, At, B0); PG8_BAR; PG8_SCHED;
            PG8_STAGE(PG8_SB(0, 1), b2 + hstep, voffB);
            PG8_WAIT_V(6); PG8_BAR; PG8_MMA(1, 1, At, B1); PG8_BAR;
            PG8_LDB(B0, 1, 0); PG8_SCHED; PG8_LDA(At, 1, 0); PG8_STAGE(PG8_SA(0, 1), a2 + hstep, voffA);
            PG8_WAIT_L(8); PG8_BAR; PG8_WAIT_L(0); PG8_MMA(0, 0, At, B0); PG8_BAR; PG8_SCHED;
            PG8_LDB(B1, 1, 1); PG8_STAGE(PG8_SB(1, 0), b3, voffB);
            PG8_BAR; PG8_WAIT_L(0); PG8_MMA(0, 1, At, B1); PG8_BAR;
            PG8_LDA(At, 1, 1); PG8_STAGE(PG8_SA(1, 0), a3, voffA);
            PG8_BAR; PG8_WAIT_L(0); PG8_MMA(1, 0, At, B0); PG8_BAR; PG8_SCHED;
            PG8_STAGE(PG8_SB(1, 1), b3 + hstep, voffB);
            PG8_WAIT_V(6); PG8_BAR; PG8_MMA(1, 1, At, B1); PG8_BAR;
            }
        }
        if constexpr (ALIGN_EPI) { if (wr == 0) PG8_BAR; }
        if constexpr (!Epi::AFTER_DRAIN) { E(acc, cur, wr, wc, fr, fq); S.done(cur); }
        if (!has_next) break;
#pragma unroll
        for (int a = 0; a < 2; ++a)
#pragma unroll
            for (int b = 0; b < 2; ++b)
#pragma unroll
                for (int m = 0; m < 4; ++m)
#pragma unroll
                    for (int n = 0; n < 2; ++n) acc[a][b][m][n] = (f32x4){0.f, 0.f, 0.f, 0.f};
        cur = nxt; cA = nA; cB = nB; ++ui;
        if constexpr (ALIGN_EPI) { if (wr == 1) PG8_BAR; }
    }
    PG8_WAIT_V(0);
    if constexpr (!ALIGN_EPI) { if (wr == 0) PG8_BAR; }
    PG8_BAR;
    if constexpr (Epi::AFTER_DRAIN) { E.fused(acc, cur, wr, wc, fr, fq, lds, wid, lane); S.done(cur); }
#undef PG8_SA
#undef PG8_SB
#undef PG8_STAGE
#undef PG8_LDA
#undef PG8_LDB
#undef PG8_MMA
#undef PG8_WAIT_V
#undef PG8_WAIT_L
#undef PG8_BAR
#undef PG8_SCHED
}
}

#define LAS __attribute__((address_space(3)))
typedef unsigned short bf16_t;
typedef short bf16x8 __attribute__((ext_vector_type(8)));
typedef float f32x4 __attribute__((ext_vector_type(4)));
typedef float f32x16 __attribute__((ext_vector_type(16)));
typedef unsigned u32x4 __attribute__((ext_vector_type(4)));
typedef unsigned u32x2 __attribute__((ext_vector_type(2)));
using pg8::cvtpk;

constexpr int NTOK = 10240, NCTX = 8192, DM = 1024, INW = 2816, DFF = 4096, NLAYER = 4;
constexpr int LDS_BYTES = 147456;
constexpr size_t MiB = 1u << 20;
constexpr size_t WS_MOD = 1 * MiB, WS_ROPE = WS_MOD + 512 * 1024, WS_WIN = 2 * MiB, WS_WOUT = 24 * MiB, WS_WUP = 32 * MiB, WS_WDN = 64 * MiB, WS_H = 96 * MiB,
                 WS_KL = 116 * MiB, WS_VTL = 128 * MiB, WS_VTC = 140 * MiB, WS_VST = 148 * MiB, WS_MIX = 154 * MiB, WS_P = 176 * MiB, WS_A = 154 * MiB, WS_END = 234 * MiB;
constexpr size_t WIN_L = (size_t)INW * DM, WOUT_L = (size_t)DM * DM, WUP_L = (size_t)DFF * DM, WDN_L = (size_t)DM * DFF;
constexpr size_t KL_L = (size_t)2 * 1536 * 512, VTL_L = (size_t)2 * 512 * 1536;

struct Params {
    const float *x_prompt, *x_sample, *cache_k, *cache_v, *c, *c_ctx, *w_mod, *b_mod, *norm_mix, *norm_mlp, *w_in, *lam_q1, *lam_k1, *lam_q2, *lam_k2, *subln,
                *conv_w, *conv_b, *w_s, *b_s, *w_out, *w_up, *w_down, *norm_final;
    float* out; unsigned char* ws;
    long long ph_lo, ph_hi;
};

__device__ __forceinline__ float wave_sum(float v) {
#pragma unroll
    for (int o = 1; o < 64; o <<= 1) v += __shfl_xor(v, o);
    return v;
}
__device__ __forceinline__ float xhalf_max(float v) { auto rr = __builtin_amdgcn_permlane32_swap(__float_as_uint(v), __float_as_uint(v), false, false); return fmaxf(__uint_as_float(rr[0]), __uint_as_float(rr[1])); }
__device__ __forceinline__ float xhalf_sum(float v) { auto rr = __builtin_amdgcn_permlane32_swap(__float_as_uint(v), __float_as_uint(v), false, false); return __uint_as_float(rr[0]) + __uint_as_float(rr[1]); }
__device__ __forceinline__ float bf2f(unsigned short b) { return __uint_as_float((unsigned)b << 16); }

__device__ __forceinline__ void transpose_item(const float* W, int N, bf16_t* WT, int ldo, LAS float* scr, int item, int lane) {
    const int nblk = N / 32, kb = item / nblk, nb = item % nblk, k0 = 64 * kb, n0 = 32 * nb;
#pragma unroll 8
    for (int i = 0; i < 32; ++i) { const int kk = 2 * i + (lane >> 5); scr[kk * 33 + (lane & 31)] = W[(size_t)(k0 + kk) * N + n0 + (lane & 31)]; }
    asm volatile("s_waitcnt lgkmcnt(0)" ::: "memory");
    const int c = lane & 7;
#pragma unroll
    for (int j = 0; j < 4; ++j) { const int n = (lane >> 3) + 8 * j; const LAS float* s = scr + (8 * c) * 33 + n;
        u32x4 o; o.x = cvtpk(s[0 * 33], s[1 * 33]); o.y = cvtpk(s[2 * 33], s[3 * 33]); o.z = cvtpk(s[4 * 33], s[5 * 33]); o.w = cvtpk(s[6 * 33], s[7 * 33]);
        *(u32x4*)(WT + (size_t)(n0 + n) * ldo + k0 + 8 * c) = o; }
    asm volatile("s_waitcnt lgkmcnt(0)" ::: "memory");
}

constexpr int STASH_OFF = 144000;
__device__ __forceinline__ const float* ld_param(LAS unsigned char* lds, int i) {
    unsigned off = STASH_OFF; asm volatile("" : "+s"(off));
    volatile LAS unsigned* s = (volatile LAS unsigned*)(lds + off) + 2 * i; unsigned lo = s[0], hi = s[1];
    lo = __builtin_amdgcn_readfirstlane(lo); hi = __builtin_amdgcn_readfirstlane(hi);
    return (const float*)(((unsigned long long)hi << 32) | (unsigned long long)lo);
}
__device__ __forceinline__ Params load_params(LAS unsigned char* lds, unsigned char* ws, float* out) {
    Params q; q.x_prompt = ld_param(lds, 0); q.x_sample = ld_param(lds, 1); q.cache_k = ld_param(lds, 2); q.cache_v = ld_param(lds, 3); q.c = ld_param(lds, 4); q.c_ctx = ld_param(lds, 5);
    q.w_mod = ld_param(lds, 6); q.b_mod = ld_param(lds, 7); q.norm_mix = ld_param(lds, 8); q.norm_mlp = ld_param(lds, 9); q.w_in = ld_param(lds, 10); q.lam_q1 = ld_param(lds, 11);
    q.lam_k1 = ld_param(lds, 12); q.lam_q2 = ld_param(lds, 13); q.lam_k2 = ld_param(lds, 14); q.subln = ld_param(lds, 15); q.conv_w = ld_param(lds, 16); q.conv_b = ld_param(lds, 17);
    q.w_s = ld_param(lds, 18); q.b_s = ld_param(lds, 19); q.w_out = ld_param(lds, 20); q.w_up = ld_param(lds, 21); q.w_down = ld_param(lds, 22); q.norm_final = ld_param(lds, 23);
    q.out = out; q.ws = ws; q.ph_lo = 0; q.ph_hi = 0; return q;
}
__device__ __forceinline__ void prologue_phase(const Params& p, LAS unsigned char* lds, int G, int bid, int tid, int wave, int lane) {
    unsigned char* ws = p.ws;
    LAS float* scr = (LAS float*)(lds + wave * 8704);
    LAS float* sc = (LAS float*)(lds + 69632);
    LAS float* red = (LAS float*)(lds + 69632 + 12288);
    float* mod = (float*)(ws + WS_MOD);
    for (int i = tid; i < 3072; i += 512) { const int s = i >> 10, k = i & 1023; const float v = s == 0 ? p.c_ctx[k] : p.c[(s - 1) * 1024 + k]; sc[i] = v / (1.f + __expf(-v)); }
    __syncthreads();
    for (int item = bid; item < 192; item += G) {
        const int d = item / 48, cgp = item % 48; const float* W = p.w_mod + (size_t)d * 1024 * 6144 + cgp * 128 + 2 * lane;
        float a00 = 0.f, a01 = 0.f, a10 = 0.f, a11 = 0.f, a20 = 0.f, a21 = 0.f; const int k0 = wave * 128;
#pragma unroll 16
        for (int kk = 0; kk < 128; ++kk) { const int k = k0 + kk; const float2 w = *(const float2*)(W + (size_t)k * 6144); const float s0 = sc[k], s1 = sc[1024 + k], s2 = sc[2048 + k];
            a00 += s0 * w.x; a01 += s0 * w.y; a10 += s1 * w.x; a11 += s1 * w.y; a20 += s2 * w.x; a21 += s2 * w.y; }
        red[(wave * 3 + 0) * 128 + 2 * lane] = a00; red[(wave * 3 + 0) * 128 + 2 * lane + 1] = a01;
        red[(wave * 3 + 1) * 128 + 2 * lane] = a10; red[(wave * 3 + 1) * 128 + 2 * lane + 1] = a11;
        red[(wave * 3 + 2) * 128 + 2 * lane] = a20; red[(wave * 3 + 2) * 128 + 2 * lane + 1] = a21;
        __syncthreads();
        if (tid < 384) { const int s = tid >> 7, col = tid & 127; float sum = p.b_mod[d * 6144 + cgp * 128 + col];
#pragma unroll
            for (int w = 0; w < 8; ++w) sum += red[(w * 3 + s) * 128 + col];
            mod[(d * 3 + s) * 6144 + cgp * 128 + col] = sum; }
        __syncthreads();
    }
    { const int gt = bid * 512 + tid; if (gt < 1024) { const int pos = gt >> 4, i = gt & 15; const float inv = exp2f(-(float)i * (13.287712379549449f / 16.f)); const float ang = (float)pos * inv;
        float* rc = (float*)(ws + WS_ROPE); rc[gt] = cosf(ang); rc[1024 + gt] = sinf(ang); } }
    const int vw = wave * G + bid, NVW = 8 * G;
    constexpr int I_IN = 16 * 88, I_OUT = 16 * 32, I_UP = 16 * 128, I_DN = 64 * 32, I_L = I_IN + I_OUT + I_UP + I_DN, I_CV = 8 * 16, I_ALL = 4 * I_L + 8 * I_CV;
    for (int it = vw; it < I_ALL; it += NVW) {
        if (it < 4 * I_L) { const int d = it / I_L; int r = it % I_L;
            if (r < I_IN) { transpose_item(p.w_in + (size_t)d * WIN_L, INW, (bf16_t*)(ws + WS_WIN) + (size_t)d * WIN_L, DM, scr, r, lane); continue; } r -= I_IN;
            if (r < I_OUT) { transpose_item(p.w_out + (size_t)d * WOUT_L, DM, (bf16_t*)(ws + WS_WOUT) + (size_t)d * WOUT_L, DM, scr, r, lane); continue; } r -= I_OUT;
            if (r < I_UP) { transpose_item(p.w_up + (size_t)d * WUP_L, DFF, (bf16_t*)(ws + WS_WUP) + (size_t)d * WUP_L, DM, scr, r, lane); continue; } r -= I_UP;
            transpose_item(p.w_down + (size_t)d * WDN_L, DM, (bf16_t*)(ws + WS_WDN) + (size_t)d * WDN_L, DFF, scr, r, lane);
        } else { const int r = it - 4 * I_L, bd = r / I_CV, b = bd >> 2, d = bd & 3;
            transpose_item(p.cache_v + (size_t)bd * 512 * 512, 512, (bf16_t*)(ws + WS_VTL) + (size_t)d * VTL_L + (size_t)b * 512 * 1536, 1536, scr, r % I_CV, lane); }
    }
    for (int i = bid * 512 + tid; i < 2 * 4 * 512 * 64; i += G * 512) { const int c8 = (i & 63) * 8, key = (i >> 6) & 511, bd = i >> 15, b = bd >> 2, d = bd & 3;
        const float* src = p.cache_k + ((size_t)bd * 512 + key) * 512 + c8; const f32x4 v0 = *(const f32x4*)src, v1 = *(const f32x4*)(src + 4);
        u32x4 o; o.x = cvtpk(v0[0], v0[1]); o.y = cvtpk(v0[2], v0[3]); o.z = cvtpk(v1[0], v1[1]); o.w = cvtpk(v1[2], v1[3]);
        *(u32x4*)((bf16_t*)(ws + WS_KL) + (size_t)d * KL_L + ((size_t)b * 1536 + key) * 512 + c8) = o; }
}

__device__ __forceinline__ void norm_phase(const Params& p, int layer, int which, int G, int bid, int wave, int lane) {
    const float* mod = (const float*)(p.ws + WS_MOD); const float* xbuf = p.out; bf16_t* H = (bf16_t*)(p.ws + WS_H);
    const float* g = (which ? p.norm_mlp : p.norm_mix) + layer * 1024;
    const bool first = (layer == 0 && which == 0);
    for (int row = wave * G + bid; row < NTOK; row += 8 * G) {
        const float* xr = first ? (row < NCTX ? p.x_prompt + (size_t)row * 1024 : p.x_sample + (size_t)(row - NCTX) * 1024) : xbuf + (size_t)row * 1024;
        const int s = row < NCTX ? 0 : 1 + ((row - NCTX) >> 10);
        const float* sh = mod + (size_t)((layer * 3 + s) * 6 + (which ? 3 : 0)) * 1024; const float* scl = sh + 1024;
        f32x4 v[4]; float ss = 0.f;
#pragma unroll
        for (int j = 0; j < 4; ++j) { v[j] = *(const f32x4*)(xr + 4 * lane + 256 * j); ss += (v[j][0] * v[j][0] + v[j][1] * v[j][1]) + (v[j][2] * v[j][2] + v[j][3] * v[j][3]); }
        const float rstd = rsqrtf(wave_sum(ss) * (1.f / 1024.f) + 1e-6f);
#pragma unroll
        for (int j = 0; j < 4; ++j) { const int c = 4 * lane + 256 * j; const f32x4 gg = *(const f32x4*)(g + c), a = *(const f32x4*)(scl + c), b = *(const f32x4*)(sh + c);
            const f32x4 y = v[j] * rstd * gg * (a + 1.f) + b; u32x2 w; w.x = cvtpk(y[0], y[1]); w.y = cvtpk(y[2], y[3]); *(u32x2*)(H + (size_t)row * 1024 + c) = w; }
    }
}
__device__ __forceinline__ void final_norm_phase(const Params& p, int G, int bid, int wave, int lane) {
    for (int row = wave * G + bid; row < NTOK; row += 8 * G) {
        float* xr = p.out + (size_t)row * 1024; f32x4 v[4]; float ss = 0.f;
#pragma unroll
        for (int j = 0; j < 4; ++j) { v[j] = *(const f32x4*)(xr + 4 * lane + 256 * j); ss += (v[j][0] * v[j][0] + v[j][1] * v[j][1]) + (v[j][2] * v[j][2] + v[j][3] * v[j][3]); }
        const float rstd = rsqrtf(wave_sum(ss) * (1.f / 1024.f) + 1e-6f);
#pragma unroll
        for (int j = 0; j < 4; ++j) { const int c = 4 * lane + 256 * j; *(f32x4*)(xr + c) = v[j] * rstd * *(const f32x4*)(p.norm_final + c); }
    }
}

struct AttnState { f32x16 O0[4], O1[4]; float m0, m1, l0, l1; };
__device__ __forceinline__ void sm_step(f32x16& S, float& m, float& l, f32x16 (&O)[4], bf16x8 (&P)[2]) {
    float mx = fmaxf(S[0], S[1]);
#pragma unroll
    for (int r = 2; r < 16; ++r) mx = fmaxf(mx, S[r]);
    mx = xhalf_max(mx);
    const float mn = fmaxf(m, mx);
    if (__any(mn > m)) { const float al = __builtin_amdgcn_exp2f(m - mn); l *= al;
#pragma unroll
        for (int b = 0; b < 4; ++b)
#pragma unroll
            for (int r = 0; r < 16; ++r) O[b][r] *= al; }
    m = mn; float ps = 0.f;
#pragma unroll
    for (int r = 0; r < 16; ++r) { S[r] = __builtin_amdgcn_exp2f(S[r] - mn); ps += S[r]; }
    l += ps;
#pragma unroll
    for (int s = 0; s < 2; ++s) { u32x4 w; w.x = cvtpk(S[8 * s], S[8 * s + 1]); w.y = cvtpk(S[8 * s + 2], S[8 * s + 3]); w.z = cvtpk(S[8 * s + 4], S[8 * s + 5]); w.w = cvtpk(S[8 * s + 6], S[8 * s + 7]); P[s] = __builtin_bit_cast(bf16x8, w); }
}
__device__ __forceinline__ void attn_tiles(AttnState& st, const bf16_t* Q, int qpitch, const bf16_t* K, int kpitch, const bf16_t* Vt, int vpitch, int ntiles, LAS unsigned char* qlds, int lane) {
    const int r32 = lane & 31, hi = lane >> 5;
    LAS bf16x8* qs = (LAS bf16x8*)qlds + lane;
#pragma unroll
    for (int c = 0; c < 2; ++c)
#pragma unroll
        for (int d0 = 0; d0 < 4; ++d0) qs[(c * 4 + d0) * 64] = *(const bf16x8*)(Q + (size_t)r32 * qpitch + c * 64 + d0 * 16 + hi * 8);
#pragma unroll
    for (int b = 0; b < 4; ++b) { st.O0[b] = f32x16{}; st.O1[b] = f32x16{}; }
    st.m0 = -1e30f; st.m1 = -1e30f; st.l0 = 0.f; st.l1 = 0.f;
    const int pr = (r32 & ~12) | ((r32 & 4) << 1) | ((r32 & 8) >> 1);
    const bf16_t* kp = K + (size_t)pr * kpitch + hi * 8; const bf16_t* vp = Vt + (size_t)r32 * vpitch + hi * 8;
    for (int t = 0; t < ntiles; ++t) {
        bf16x8 P0[2], P1[2];
        { bf16x8 kf[4];
#pragma unroll
          for (int d0 = 0; d0 < 4; ++d0) kf[d0] = *(const bf16x8*)(kp + d0 * 16);
          f32x16 S = f32x16{};
#pragma unroll
          for (int d0 = 0; d0 < 4; ++d0) S = __builtin_amdgcn_mfma_f32_32x32x16_bf16(kf[d0], qs[d0 * 64], S, 0, 0, 0);
          sm_step(S, st.m0, st.l0, st.O0, P0); }
        { bf16x8 kf[4];
#pragma unroll
          for (int d0 = 0; d0 < 4; ++d0) kf[d0] = *(const bf16x8*)(kp + 64 + d0 * 16);
          f32x16 S = f32x16{};
#pragma unroll
          for (int d0 = 0; d0 < 4; ++d0) S = __builtin_amdgcn_mfma_f32_32x32x16_bf16(kf[d0], qs[(4 + d0) * 64], S, 0, 0, 0);
          sm_step(S, st.m1, st.l1, st.O1, P1); }
#pragma unroll
        for (int s = 0; s < 2; ++s)
#pragma unroll
            for (int b = 0; b < 4; ++b) { const bf16x8 vf = *(const bf16x8*)(vp + (size_t)(b * 32) * vpitch + s * 16);
                st.O0[b] = __builtin_amdgcn_mfma_f32_32x32x16_bf16(vf, P0[s], st.O0[b], 0, 0, 0);
                st.O1[b] = __builtin_amdgcn_mfma_f32_32x32x16_bf16(vf, P1[s], st.O1[b], 0, 0, 0); }
        kp += (size_t)32 * kpitch; vp += 32;
    }
}
__device__ __forceinline__ void attn_finish_single(AttnState& st, float lam, const float* subln, float oscale, bf16_t* out, int lane) {
    const int r32 = lane & 31, hi = lane >> 5;
    const float i0 = 1.f / xhalf_sum(st.l0), i1 = lam / xhalf_sum(st.l1); float ss = 0.f;
#pragma unroll
    for (int b = 0; b < 4; ++b)
#pragma unroll
        for (int r = 0; r < 16; ++r) { const float R = st.O0[b][r] * i0 - st.O1[b][r] * i1; st.O0[b][r] = R; ss += R * R; }
    const float rstd = rsqrtf(xhalf_sum(ss) * (1.f / 128.f) + 1e-6f) * oscale;
#pragma unroll
    for (int b = 0; b < 4; ++b)
#pragma unroll
        for (int g = 0; g < 4; ++g) { const int dv = 32 * b + 8 * g + 4 * hi; const f32x4 sg = *(const f32x4*)(subln + dv);
            u32x2 w; w.x = cvtpk(st.O0[b][4 * g] * rstd * sg[0], st.O0[b][4 * g + 1] * rstd * sg[1]); w.y = cvtpk(st.O0[b][4 * g + 2] * rstd * sg[2], st.O0[b][4 * g + 3] * rstd * sg[3]);
            *(u32x2*)(out + (size_t)r32 * 1024 + dv) = w; }
}
__device__ __forceinline__ void attn_finish_split(AttnState& st, float lam, const float* subln, float oscale, bf16_t* out, LAS unsigned char* lds, int wave, int lane) {
    const int r32 = lane & 31, hi = lane >> 5;
    LAS float* red = (LAS float*)lds;
    LAS float* stt = (LAS float*)(lds + 131072);
    LAS float* ssq = stt + 1024;
    const float l0 = xhalf_sum(st.l0), l1 = xhalf_sum(st.l1);
    if (hi == 0) { stt[(wave * 4 + 0) * 32 + r32] = st.m0; stt[(wave * 4 + 1) * 32 + r32] = l0; stt[(wave * 4 + 2) * 32 + r32] = st.m1; stt[(wave * 4 + 3) * 32 + r32] = l1; }
    __syncthreads();
    float M0 = -1e30f, M1 = -1e30f;
#pragma unroll
    for (int w = 0; w < 8; ++w) { M0 = fmaxf(M0, stt[(w * 4 + 0) * 32 + r32]); M1 = fmaxf(M1, stt[(w * 4 + 2) * 32 + r32]); }
    float L0 = 0.f, L1 = 0.f;
#pragma unroll
    for (int w = 0; w < 8; ++w) { L0 += stt[(w * 4 + 1) * 32 + r32] * __builtin_amdgcn_exp2f(stt[(w * 4 + 0) * 32 + r32] - M0); L1 += stt[(w * 4 + 3) * 32 + r32] * __builtin_amdgcn_exp2f(stt[(w * 4 + 2) * 32 + r32] - M1); }
    const float f0 = __builtin_amdgcn_exp2f(st.m0 - M0) / L0, f1 = lam * __builtin_amdgcn_exp2f(st.m1 - M1) / L1;
#pragma unroll
    for (int b = 0; b < 4; ++b)
#pragma unroll
        for (int r = 0; r < 16; ++r) { red[(wave * 64 + b * 16 + r) * 64 + lane] = st.O0[b][r] * f0 - st.O1[b][r] * f1; if ((r & 3) == 3) asm volatile("" ::: "memory"); }
    __syncthreads();
    float R[8]; float ss = 0.f;
#pragma unroll
    for (int j = 0; j < 8; ++j) { float sum = 0.f;
#pragma unroll
        for (int w = 0; w < 8; ++w) sum += red[(w * 64 + wave * 8 + j) * 64 + lane];
        R[j] = sum; ss += sum * sum; }
    ss = xhalf_sum(ss);
    if (hi == 0) ssq[wave * 32 + r32] = ss;
    __syncthreads();
    float tot = 0.f;
#pragma unroll
    for (int w = 0; w < 8; ++w) tot += ssq[w * 32 + r32];
    const float rstd = rsqrtf(tot * (1.f / 128.f) + 1e-6f) * oscale;
#pragma unroll
    for (int g = 0; g < 2; ++g) { const int dv = 32 * (wave >> 1) + 16 * (wave & 1) + 8 * g + 4 * hi; const f32x4 sg = *(const f32x4*)(subln + dv);
        u32x2 w; w.x = cvtpk(R[4 * g] * rstd * sg[0], R[4 * g + 1] * rstd * sg[1]); w.y = cvtpk(R[4 * g + 2] * rstd * sg[2], R[4 * g + 3] * rstd * sg[3]);
        *(u32x2*)(out + (size_t)r32 * 1024 + dv) = w; }
    __syncthreads();
}

__device__ __forceinline__ void mixer_phase(const Params& p, int layer, LAS unsigned char* lds, int G, int bid, int wave, int lane) {
    unsigned char* ws = p.ws;
    const bf16_t* P = (const bf16_t*)(ws + WS_P); bf16_t* MIX = (bf16_t*)(ws + WS_MIX);
    const bf16_t* KL = (const bf16_t*)(ws + WS_KL) + (size_t)layer * KL_L; const bf16_t* VtL = (const bf16_t*)(ws + WS_VTL) + (size_t)layer * VTL_L;
    const bf16_t* VtC = (const bf16_t*)(ws + WS_VTC); const bf16_t* VsT = (const bf16_t*)(ws + WS_VST);
    const float lam_init = 0.8f - 0.6f * __expf(-0.3f * (float)layer);
    const float s1 = wave_sum(p.lam_q1[layer * 64 + lane] * p.lam_k1[layer * 64 + lane]), s2 = wave_sum(p.lam_q2[layer * 64 + lane] * p.lam_k2[layer * 64 + lane]);
    const float lam = __expf(s1) - __expf(s2) + lam_init; const float oscale = 1.f - lam_init;
    const float* subln = p.subln + layer * 128;
    for (int it = bid; it < 256; it += G) {
        const int b = it >> 7, h = (it >> 5) & 3, qt = it & 31; const int tok0 = NCTX + b * 1024 + qt * 32;
        AttnState st;
        attn_tiles(st, P + (size_t)tok0 * INW + h * 128, INW, KL + ((size_t)b * 1536 + 192 * wave) * 512 + h * 128, 512, VtL + (size_t)((b * 4 + h) * 128) * 1536 + 192 * wave, 1536, 6, lds + wave * 8192, lane);
        attn_finish_split(st, lam, subln, oscale, MIX + (size_t)tok0 * 1024 + h * 128, lds, wave, lane);
    }
    if (wave < 4) {
        for (int it = wave * G + bid; it < 1024; it += 4 * G) {
            const int b = it >> 5, h = (it >> 3) & 3, qt = it & 7; const int tok0 = b * 256 + qt * 32;
            AttnState st;
            attn_tiles(st, P + (size_t)tok0 * INW + h * 128, INW, P + (size_t)(b * 256) * INW + 512 + h * 128, INW, VtC + (size_t)((b * 4 + h) * 128) * 256, 256, 8, lds + wave * 8192, lane);
            attn_finish_single(st, lam, subln, oscale, MIX + (size_t)tok0 * 1024 + h * 128, lane);
        }
    } else {
        const float* cw = p.conv_w + layer * 768; const float* cb = p.conv_b + layer * 256;
        for (int i = ((wave - 4) * G + bid) * 64 + lane; i < NTOK * 32; i += 4 * G * 64) {
            const int tok = i >> 5, c8 = (i & 31) * 8; const bf16_t* row = P + (size_t)tok * INW; const int sl = tok < NCTX ? 256 : 1024, pos = tok & (sl - 1);
            const u32x4 gb = *(const u32x4*)(row + 1536 + c8), gc1 = *(const u32x4*)(row + 1792 + c8), xi1 = *(const u32x4*)(row + 2048 + c8);
            u32x4 gc0 = {0u, 0u, 0u, 0u}, xi0 = gc0, gc2 = gc0, xi2 = gc0;
            if (pos > 0) { gc0 = *(const u32x4*)(row - INW + 1792 + c8); xi0 = *(const u32x4*)(row - INW + 2048 + c8); }
            if (pos < sl - 1) { gc2 = *(const u32x4*)(row + INW + 1792 + c8); xi2 = *(const u32x4*)(row + INW + 2048 + c8); }
            u32x4 o;
#pragma unroll
            for (int e = 0; e < 4; ++e) { float r2[2];
#pragma unroll
                for (int hh = 0; hh < 2; ++hh) { const int sh = hh * 16; const int ch = c8 + 2 * e + hh;
#define ex(w) __uint_as_float(((w) >> sh) << 16)
                    const float g0 = ex(gc0[e]) * ex(xi0[e]), g1 = ex(gc1[e]) * ex(xi1[e]), g2 = ex(gc2[e]) * ex(xi2[e]);
                    r2[hh] = ex(gb[e]) * (g0 * cw[ch] + g1 * cw[256 + ch] + g2 * cw[512 + ch] + cb[ch]); }
#undef ex
                o[e] = cvtpk(r2[0], r2[1]); }
            *(u32x4*)(MIX + (size_t)tok * 1024 + 512 + c8) = o;
        }
        const float* wsl = p.w_s + (size_t)layer * 4 * 128 * 128; const float* bsl = p.b_s + layer * 512;
        const int r32 = lane & 31, hi = lane >> 5;
        for (int it = (wave - 4) * G + bid; it < 80 * 32; it += 4 * G) {
            const int ch = it >> 5, g = (it >> 3) & 3, db = (it >> 2) & 1, pb = it & 3;
            const bf16_t* ap = VsT + (size_t)(g * 64 + db * 32 + r32) * NTOK + ch * 128 + hi * 8;
            const float* bp = wsl + (size_t)(g * 128 + pb * 32 + r32) * 128 + hi * 8;
            f32x16 D = f32x16{};
#pragma unroll
            for (int ks = 0; ks < 8; ++ks) { const bf16x8 a = *(const bf16x8*)(ap + ks * 16); const f32x4 b0 = *(const f32x4*)(bp + ks * 16), b1 = *(const f32x4*)(bp + ks * 16 + 4);
                u32x4 w; w.x = cvtpk(b0[0], b0[1]); w.y = cvtpk(b0[2], b0[3]); w.z = cvtpk(b1[0], b1[1]); w.w = cvtpk(b1[2], b1[3]);
                D = __builtin_amdgcn_mfma_f32_32x32x16_bf16(a, __builtin_bit_cast(bf16x8, w), D, 0, 0, 0); }
            const int tok = ch * 128 + pb * 32 + r32; const float bias = bsl[g * 128 + pb * 32 + r32];
#pragma unroll
            for (int q4 = 0; q4 < 4; ++q4) { const int d = g * 64 + db * 32 + 8 * q4 + 4 * hi; const u32x2 uu = *(const u32x2*)(P + (size_t)tok * INW + 2304 + d);
                u32x2 w; w.x = cvtpk(__uint_as_float(uu.x << 16) * (D[4 * q4] + bias), __uint_as_float(uu.x & 0xffff0000u) * (D[4 * q4 + 1] + bias));
                w.y = cvtpk(__uint_as_float(uu.y << 16) * (D[4 * q4 + 2] + bias), __uint_as_float(uu.y & 0xffff0000u) * (D[4 * q4 + 3] + bias));
                *(u32x2*)(MIX + (size_t)tok * 1024 + 768 + d) = w; }
        }
    }
}


#define XB_TMO      128
#define XB_XCNT(j)  (256  + 64 * (j))
#define XB_XSUB(j)  (1280 + 64 * (j))
#define XB_XGEN(j)  (2304 + 64 * (j))
#define XB_TOP      3328
#define XB_TOPGEN   3392
#define XCD_BAR_WORDS 3456
#define XB_SPIN_CAP (1u << 22)
__device__ __forceinline__ unsigned xb_ld(unsigned* p)              { return __hip_atomic_load(p, __ATOMIC_RELAXED, __HIP_MEMORY_SCOPE_AGENT); }
__device__ __forceinline__ unsigned xb_add(unsigned* p, unsigned v) { return __hip_atomic_fetch_add(p, v, __ATOMIC_RELAXED, __HIP_MEMORY_SCOPE_AGENT); }
__device__ __forceinline__ unsigned xb_xcc_id() { return (unsigned)__builtin_amdgcn_s_getreg((3 << 11) | 20) & 0xFu; }
#define XB_SPIN(cond, bar) do { unsigned _sp = 0; while (cond) { __builtin_amdgcn_s_sleep(1); \
    if ((++_sp & 255u) == 0u) { if (xb_ld(&(bar)[XB_TMO])) break; if (_sp > XB_SPIN_CAP) { atomicAdd(&(bar)[XB_TMO], 1u); break; } } } } while (0)
__device__ __forceinline__ void xcd_barrier_complete(unsigned* bar, unsigned x, unsigned G, unsigned& nloc, unsigned& nx) {
    unsigned sum, cnt, mine, sp = 0u;
    for (;;) {
        sum = 0u; cnt = 0u; mine = 0u;
#pragma unroll
        for (unsigned j = 0; j < 16; ++j) { const unsigned c = xb_ld(&bar[XB_XCNT(j)]); sum += c; cnt += (c > 0u) ? 1u : 0u; mine = (j == x) ? c : mine; }
        if (sum == G) break;
        __builtin_amdgcn_s_sleep(1);
        if ((++sp & 255u) == 0u) { if (xb_ld(&bar[XB_TMO])) break; if (sp > XB_SPIN_CAP) { atomicAdd(&bar[XB_TMO], 1u); break; } }
    }
    nloc = mine > 0u ? mine : 1u; nx = cnt > 0u ? cnt : 1u;
}
__device__ __forceinline__ void xcd_barrier(unsigned* bar, volatile LAS unsigned* st, bool leader, unsigned G) {
    asm volatile("s_waitcnt vmcnt(0)" ::: "memory");
    __syncthreads();
    if (leader) {
        __builtin_amdgcn_s_waitcnt(0);
        const unsigned x = xb_xcc_id();
        unsigned nloc = st[0], nx = st[1];
        if (nloc == 0u) { xcd_barrier_complete(bar, x, G, nloc, nx); st[0] = nloc; st[1] = nx; }
        const unsigned old = xb_add(&bar[XB_XSUB(x)], 1u);
        const unsigned gen = old / nloc;
        if (old + 1u == (gen + 1u) * nloc) {
            __builtin_amdgcn_fence(__ATOMIC_RELEASE, "agent");
            asm volatile("s_waitcnt vmcnt(0)" ::: "memory");
            const unsigned og = xb_add(&bar[XB_TOP], 1u);
            const unsigned tg = og / nx;
            if (og + 1u == (tg + 1u) * nx) xb_add(&bar[XB_TOPGEN], 1u);
            else XB_SPIN(xb_ld(&bar[XB_TOPGEN]) == tg, bar);
            __builtin_amdgcn_fence(__ATOMIC_ACQUIRE, "agent");
            xb_add(&bar[XB_XGEN(x)], 1u);
            asm volatile("s_waitcnt vmcnt(0)" ::: "memory");
        } else {
            XB_SPIN(xb_ld(&bar[XB_XGEN(x)]) == gen, bar);
            __builtin_amdgcn_fence(__ATOMIC_ACQUIRE, "agent");
            asm volatile("s_waitcnt vmcnt(0)" ::: "memory");
        }
    }
    __syncthreads();
}
__global__ void __launch_bounds__(512, 2) mega(Params p) {
    extern __shared__ __attribute__((aligned(16))) unsigned char lds_raw[];
    LAS unsigned char* lds = (LAS unsigned char*)lds_raw;
    const int wave_k = __builtin_amdgcn_readfirstlane(threadIdx.x >> 6), G_k = gridDim.x, bid_k = blockIdx.x;
    unsigned char* ws_k = p.ws; float* out_k = p.out;
    const int lo = (int)p.ph_lo, hi = (int)p.ph_hi; int ph = 0;
    if (threadIdx.x == 0) { LAS unsigned long long* st = (LAS unsigned long long*)(lds + STASH_OFF);
        st[0] = (unsigned long long)p.x_prompt; st[1] = (unsigned long long)p.x_sample; st[2] = (unsigned long long)p.cache_k; st[3] = (unsigned long long)p.cache_v; st[4] = (unsigned long long)p.c; st[5] = (unsigned long long)p.c_ctx;
        st[6] = (unsigned long long)p.w_mod; st[7] = (unsigned long long)p.b_mod; st[8] = (unsigned long long)p.norm_mix; st[9] = (unsigned long long)p.norm_mlp; st[10] = (unsigned long long)p.w_in; st[11] = (unsigned long long)p.lam_q1;
        st[12] = (unsigned long long)p.lam_k1; st[13] = (unsigned long long)p.lam_q2; st[14] = (unsigned long long)p.lam_k2; st[15] = (unsigned long long)p.subln; st[16] = (unsigned long long)p.conv_w; st[17] = (unsigned long long)p.conv_b;
        st[18] = (unsigned long long)p.w_s; st[19] = (unsigned long long)p.b_s; st[20] = (unsigned long long)p.w_out; st[21] = (unsigned long long)p.w_up; st[22] = (unsigned long long)p.w_down; st[23] = (unsigned long long)p.norm_final; }
    volatile LAS unsigned* bst = (volatile LAS unsigned*)(lds + STASH_OFF + 256);
    if (threadIdx.x == 0) { bst[0] = 0u; bst[1] = 0u; if (hi - lo > 1) (void)xb_add((unsigned*)p.ws + XB_XCNT(xb_xcc_id()), 1u); }
    __syncthreads();
#define PH_IN() (lo <= ph && ph < hi)
#define PH_END() do { if (lo <= ph && ph + 1 < hi) { if (hi > 1000) cg::this_grid().sync();     \
        int ln_; asm volatile("v_mbcnt_lo_u32_b32 %0, -1, 0\n\tv_mbcnt_hi_u32_b32 %0, -1, %0" : "=v"(ln_)); unsigned char* wsb_ = ws_k; int wv_ = wave_k, Gb_ = G_k; asm volatile("" : "+s"(wsb_), "+s"(wv_), "+s"(Gb_)); \
        xcd_barrier((unsigned*)wsb_, bst, wv_ == 0 && ln_ == 0, (unsigned)Gb_); } ++ph; } while (0)
#define LAUNDER() int lane2; asm volatile("v_mbcnt_lo_u32_b32 %0, -1, 0\n\tv_mbcnt_hi_u32_b32 %0, -1, %0" : "=v"(lane2)); \
    unsigned char* ws2 = ws_k; float* out2 = out_k; int G2 = G_k, bid2 = bid_k, wave2 = wave_k; asm volatile("" : "+s"(ws2), "+s"(out2), "+s"(G2), "+s"(bid2), "+s"(wave2)); const int tid2 = wave2 * 64 + lane2; (void)tid2
    if (PH_IN()) { LAUNDER(); const Params q = load_params(lds, ws2, out2); for (int rep = 0; rep < REP_PRO; ++rep) { prologue_phase(q, lds, G2, bid2, tid2, wave2, lane2); __syncthreads(); } }
    PH_END();
    if (PH_IN()) { LAUNDER(); const Params q = load_params(lds, ws2, out2); norm_phase(q, 0, 0, G2, bid2, wave2, lane2); }
    PH_END();
    for (int L = 0; L < NLAYER; ++L) {
        if (PH_IN()) {
            LAUNDER();
            pg8::Gemm g{(const bf16_t*)(ws2 + WS_H), (const bf16_t*)(ws2 + WS_WIN) + (size_t)L * WIN_L, NTOK, INW, DM}; pg8::StaticOrder S; S.init(NTOK, INW, G2, bid2);
            pg8::EpiIn E{ws2, out2, L};
            for (int rep = 0; rep < REP_GIN; ++rep) pg8::gemm_phase<pg8::EpiIn, pg8::StaticOrder, true, true>(lds, g, S, E, wave2);
        }
        PH_END();
        if (PH_IN()) { LAUNDER(); const Params q = load_params(lds, ws2, out2); for (int rep = 0; rep < REP_MIX; ++rep) { mixer_phase(q, L, lds, G2, bid2, wave2, lane2); __syncthreads(); } }
        PH_END();
        if (PH_IN()) {
            LAUNDER();
            pg8::Gemm g{(const bf16_t*)(ws2 + WS_MIX), (const bf16_t*)(ws2 + WS_WOUT) + (size_t)L * WOUT_L, NTOK, DM, DM}; pg8::StaticOrder S; S.init(NTOK, DM, G2, bid2);
            pg8::EpiRes E{ld_param(lds, 0), ld_param(lds, 1), out2, (const float*)(ws2 + WS_MOD) + (size_t)(L * 3) * 6144 + 2 * 1024, L == 0 ? 1 : 0};
            pg8::gemm_phase<pg8::EpiRes, pg8::StaticOrder, true, true>(lds, g, S, E, wave2);
        }
        PH_END();
        if (PH_IN()) { LAUNDER(); const Params q = load_params(lds, ws2, out2); norm_phase(q, L, 1, G2, bid2, wave2, lane2); }
        PH_END();
        if (PH_IN()) {
            LAUNDER();
            pg8::Gemm g{(const bf16_t*)(ws2 + WS_H), (const bf16_t*)(ws2 + WS_WUP) + (size_t)L * WUP_L, NTOK, DFF, DM}; pg8::StaticOrder S; S.init(NTOK, DFF, G2, bid2);
            pg8::EpiUp E{(bf16_t*)(ws2 + WS_A), DFF};
            for (int rep = 0; rep < REP_GUP; ++rep) pg8::gemm_phase<pg8::EpiUp, pg8::StaticOrder, true, true>(lds, g, S, E, wave2);
        }
        PH_END();
        if (PH_IN()) {
            LAUNDER();
            pg8::Gemm g{(const bf16_t*)(ws2 + WS_A), (const bf16_t*)(ws2 + WS_WDN) + (size_t)L * WDN_L, NTOK, DM, DFF}; pg8::StaticOrder S; S.init(NTOK, DM, G2, bid2);
            pg8::EpiRes E{out2, out2, out2, (const float*)(ws2 + WS_MOD) + (size_t)(L * 3) * 6144 + 5 * 1024, 0};
            pg8::gemm_phase<pg8::EpiRes, pg8::StaticOrder, true, true>(lds, g, S, E, wave2);
        }
        PH_END();
        if (PH_IN()) { LAUNDER(); const Params q = load_params(lds, ws2, out2); if (L + 1 < NLAYER) norm_phase(q, L + 1, 0, G2, bid2, wave2, lane2); else final_norm_phase(q, G2, bid2, wave2, lane2); }
        PH_END();
    }
}
constexpr int N_PHASES = 2 + 7 * NLAYER;

extern "C" void kernel_launch(void* const* d_in, const int* in_sizes, int n_in, void* d_out, int out_size, void* d_ws, size_t ws_size, hipStream_t stream) {
    static int grid = 0;
    if (grid == 0) {
        if (n_in != 24 || ws_size < WS_END) { fprintf(stderr, "kernel_launch: unexpected n_in %d / ws_size %zu\n", n_in, ws_size); grid = -1; return; }
        int dev = 0, cus = 0, per_cu = 0;
        (void)hipGetDevice(&dev); (void)hipDeviceGetAttribute(&cus, hipDeviceAttributeMultiprocessorCount, dev);
        if (hipFuncSetAttribute((const void*)mega, hipFuncAttributeMaxDynamicSharedMemorySize, LDS_BYTES) != hipSuccess) { fprintf(stderr, "kernel_launch: hipFuncSetAttribute failed\n"); }
        if (hipOccupancyMaxActiveBlocksPerMultiprocessor(&per_cu, (const void*)mega, 512, LDS_BYTES) != hipSuccess || per_cu < 1) { fprintf(stderr, "kernel_launch: occupancy query gave %d\n", per_cu); per_cu = 1; }
        (void)hipGetLastError();
        grid = cus * per_cu;
        if (grid <= 0) grid = 256;
    }
    if (grid < 0) return;
    Params p{};
    const float** dst = (const float**)&p;
    for (int i = 0; i < 24; ++i) dst[i] = (const float*)d_in[i];
    p.out = (float*)d_out; p.ws = (unsigned char*)d_ws;
    (void)hipMemsetAsync(d_ws, 0, 16384, stream);
#if MULTI_LAUNCH
    for (int ph = 0; ph < N_PHASES; ++ph) { p.ph_lo = ph; p.ph_hi = ph + 1; hipLaunchKernelGGL(mega, dim3(grid), dim3(512), LDS_BYTES, stream, p); }
#else
    p.ph_lo = 0; p.ph_hi = N_PHASES;
    void* args[] = {&p};
    hipError_t e = hipLaunchCooperativeKernel((const void*)mega, dim3(grid), dim3(512), args, LDS_BYTES, stream);
    if (e != hipSuccess) fprintf(stderr, "kernel_launch: cooperative launch failed: %s (grid %d)\n", hipGetErrorString(e), grid);
#endif
}
```

```cpp
#include <hip/hip_runtime.h>
#include <hip/hip_cooperative_groups.h>
#include <cstdio>
#include <cstdint>
namespace cg = cooperative_groups;
#ifndef REP_PRO
#define REP_PRO 1
#endif
#ifndef REP_MIX
#define REP_MIX 1
#endif
#ifndef REP_GIN
#define REP_GIN 1
#endif
#ifndef REP_GUP
#define REP_GUP 1
#endif
#ifndef MULTI_LAUNCH
#define MULTI_LAUNCH 0
#endif
namespace pg8 {
#define PG8_LAS __attribute__((address_space(3)))
typedef unsigned short bf16_t;
typedef short bf16x8 __attribute__((ext_vector_type(8)));
typedef float f32x4 __attribute__((ext_vector_type(4)));
typedef unsigned u32x4 __attribute__((ext_vector_type(4)));
constexpr int BM = 256, BK = 64, HALF = 128, HTB = HALF * BK * 2  , STAGE_BYTES = 8 * HTB, NXCD = 8, WGM = 8;

__host__ __device__ __forceinline__ int lds_byte(int r, int c) { const int st = (r >> 4) * 2 + (c >> 5), rr = r & 15, cc = c & 31, ob = rr * 64 + cc * 2; return st * 1024 + (ob ^ (((ob >> 9) & 1) << 5)); }
__host__ __device__ __forceinline__ void stage_rc(int b, int& R, int& C) { const int st = b / 1024, sb = b % 1024, swz = sb ^ (((sb >> 9) & 1) << 5); R = (st >> 1) * 16 + swz / 64; C = (st & 1) * 32 + (swz % 64) / 2; }
__host__ __device__ __forceinline__ int perm32(int rho) { const int n = rho >> 4, i = rho & 15; return 8 * (i >> 2) + 4 * n + (i & 3); }

struct Unit { int pm, pn; };
struct Gemm { const bf16_t* A; const bf16_t* Bt; int M, N, K; };

struct StaticOrder {
    int nM, nN, nwg, G, c;
    __host__ __device__ void init(int M, int N, int G_, int c_) { nM = M / BM; nN = N / BM; nwg = nM * nN; G = G_; c = c_; }
    __host__ __device__ bool next(int i, Unit& u) const {
        const long L = (long)i * G + c; if (L >= nwg) return false;
        int wgid = (int)L; { const int q = nwg / NXCD, r = nwg % NXCD, xcd = wgid % NXCD, off = wgid / NXCD; wgid = (xcd < r ? xcd * (q + 1) : r * (q + 1) + (xcd - r) * q) + off; }
        const int nig = WGM * nN, gid = wgid / nig, fm = gid * WGM, gsz = (nM - fm) < WGM ? (nM - fm) : WGM;
        u.pm = fm + ((wgid % nig) % gsz); u.pn = (wgid % nig) / gsz; return true;
    }
    __device__ __forceinline__ void a_ready(const Unit&) const {}
    __device__ __forceinline__ void done(const Unit&) const {}
};

__device__ __forceinline__ unsigned cvt_pk_bf16(float lo, float hi) { unsigned r; asm volatile("v_cvt_pk_bf16_f32 %0, %1, %2" : "=v"(r) : "v"(lo), "v"(hi)); return r; }
typedef unsigned u32x2 __attribute__((ext_vector_type(2)));
typedef float f32x2_t __attribute__((ext_vector_type(2))); typedef __bf16 bf16x2_t __attribute__((ext_vector_type(2)));
__device__ __forceinline__ unsigned cvtpk(float lo, float hi) { f32x2_t v = {lo, hi}; bf16x2_t b = __builtin_convertvector(v, bf16x2_t); return __builtin_bit_cast(unsigned, b); }
constexpr float QSCALE = 0.125f * 1.4426950408889634f;

struct EpiIn {
    static constexpr bool PERM = false, AFTER_DRAIN = false;
    unsigned char* ws; float* out; int layer;
    static __device__ __forceinline__ bool swapped(const Unit& u) { return u.pn == 4 || u.pn == 5 || u.pn == 10; }
    __device__ __forceinline__ void operator()(const f32x4 (&acc)[2][2][4][2], const Unit& u, int wr, int wc, int fr, int fq) const {
        const int pn = u.pn, pm = u.pm;
        bf16_t* P = (bf16_t*)(ws + (176u << 20)); bf16_t* KL = (bf16_t*)(ws + (116u << 20)) + (size_t)layer * (2 * 1536 * 512); bf16_t* VtC = (bf16_t*)(ws + (140u << 20));
        bf16_t* VtL = (bf16_t*)(ws + (128u << 20)) + (size_t)layer * (2 * 512 * 1536); bf16_t* VsT = (bf16_t*)(ws + (148u << 20));
        float* ck = out + (size_t)10240 * 1024; float* cv = ck + (size_t)32 * 4 * 256 * 512; const float* rc = (const float*)(ws + (1u << 20) + 512 * 1024); const float* rs = rc + 1024;
        if (pn == 4 || pn == 5 || pn == 10) {
#pragma unroll
            for (int ai = 0; ai < 2; ++ai)
#pragma unroll
                for (int m = 0; m < 4; ++m) {
                    const int R = (pn == 10 ? 0 : (pn - 4) * 256) + ai * 128 + wr * 64 + m * 16 + fr;
#pragma unroll
                    for (int bj = 0; bj < 2; ++bj)
#pragma unroll
                        for (int n = 0; n < 2; ++n) {
                            const int tl = bj * 128 + wc * 32 + n * 16 + 4 * fq;
                            const f32x4 v = acc[ai][bj][m][n]; u32x2 w; w.x = cvtpk(v[0], v[1]); w.y = cvtpk(v[2], v[3]);
                            if (pn == 10) *(u32x2*)(VsT + (size_t)R * 10240 + pm * 256 + tl) = w;
                            else if (pm < 32) { *(u32x2*)(VtC + (size_t)(pm * 512 + R) * 256 + tl) = w;
                                float* o = cv + (size_t)((pm * 4 + layer) * 256 + tl) * 512 + R; o[0] = v[0]; o[512] = v[1]; o[1024] = v[2]; o[1536] = v[3]; }
                            else { const int b = (pm - 32) >> 2, t = ((pm - 32) & 3) * 256 + tl; *(u32x2*)(VtL + (size_t)(b * 512 + R) * 1536 + 512 + t) = w; }
                        }
                }
            return;
        }
        const int row0 = pm * 256 + wr * 64 + fr, colt = pn * 256 + wc * 32 + 4 * fq;
        if (pn < 4) {
            const bool isq = pn < 2; const float sc = isq ? QSCALE : 1.f;
            if (pm < 32) {
#pragma unroll
                for (int ai = 0; ai < 2; ++ai)
#pragma unroll
                    for (int m = 0; m < 4; ++m) { const int row = row0 + ai * 128 + m * 16;
#pragma unroll
                        for (int bj = 0; bj < 2; ++bj)
#pragma unroll
                            for (int n = 0; n < 2; ++n) { const int col = colt + bj * 128 + n * 16; const f32x4 a = acc[ai][bj][m][n]; const f32x4 v = a * sc;
                                u32x2 w; w.x = cvtpk(v[0], v[1]); w.y = cvtpk(v[2], v[3]); *(u32x2*)(P + (size_t)row * 2816 + col) = w;
                                if (!isq) *(f32x4*)(ck + (size_t)((pm * 4 + layer) * 256 + (row & 255)) * 512 + (col - 512)) = a; } }
            } else {
                const int b = (pm - 32) >> 2;
#pragma unroll
                for (int ai = 0; ai < 2; ++ai)
#pragma unroll
                    for (int m = 0; m < 4; ++m) { const int row = row0 + ai * 128 + m * 16; const int tpos = (row - 8192) & 1023; const int pos = (wc & 1) ? (tpos & 63) : (tpos >> 6);
                        const f32x4 cs = *(const f32x4*)(rc + pos * 16 + 4 * fq), sn = *(const f32x4*)(rs + pos * 16 + 4 * fq);
#pragma unroll
                        for (int bj = 0; bj < 2; ++bj) { const f32x4 x1 = acc[ai][bj][m][0], x2 = acc[ai][bj][m][1];
                            const f32x4 o1 = (x1 * cs - x2 * sn) * sc, o2 = (x2 * cs + x1 * sn) * sc; const int col = colt + bj * 128;
                            u32x2 w1, w2; w1.x = cvtpk(o1[0], o1[1]); w1.y = cvtpk(o1[2], o1[3]); w2.x = cvtpk(o2[0], o2[1]); w2.y = cvtpk(o2[2], o2[3]);
                            bf16_t* dst = isq ? (P + (size_t)row * 2816 + col) : (KL + (size_t)(b * 1536 + 512 + tpos) * 512 + (col - 512));
                            *(u32x2*)dst = w1; *(u32x2*)(dst + 16) = w2; } }
            }
        } else {
#pragma unroll
            for (int ai = 0; ai < 2; ++ai)
#pragma unroll
                for (int m = 0; m < 4; ++m) { const int row = row0 + ai * 128 + m * 16;
#pragma unroll
                    for (int bj = 0; bj < 2; ++bj)
#pragma unroll
                        for (int n = 0; n < 2; ++n) { const int col = colt + bj * 128 + n * 16; const f32x4 v = acc[ai][bj][m][n];
                            u32x2 w; w.x = cvtpk(v[0], v[1]); w.y = cvtpk(v[2], v[3]); *(u32x2*)(P + (size_t)row * 2816 + col) = w; } }
        }
    }
};
struct EpiRes {
    static constexpr bool PERM = false, AFTER_DRAIN = false;
    const float* xp; const float* xs; float* xbuf; const float* gate_base; int first;
    static __device__ __forceinline__ bool swapped(const Unit&) { return false; }
    __device__ __forceinline__ void operator()(const f32x4 (&acc)[2][2][4][2], const Unit& u, int wr, int wc, int fr, int fq) const {
        const int s = u.pm < 32 ? 0 : 1 + ((u.pm - 32) >> 2); const float* gate = gate_base + s * 6144;
        const int col0 = u.pn * 256 + wc * 32 + 4 * fq;
        f32x4 gv[2][2];
#pragma unroll
        for (int bj = 0; bj < 2; ++bj)
#pragma unroll
            for (int n = 0; n < 2; ++n) gv[bj][n] = *(const f32x4*)(gate + col0 + bj * 128 + n * 16);
#pragma unroll
        for (int ai = 0; ai < 2; ++ai)
#pragma unroll
            for (int m = 0; m < 4; ++m) { const int row = u.pm * 256 + ai * 128 + wr * 64 + m * 16 + fr;
                const float* src = first ? (row < 8192 ? xp + (size_t)row * 1024 : xs + (size_t)(row - 8192) * 1024) : xbuf + (size_t)row * 1024; float* dst = xbuf + (size_t)row * 1024;
#pragma unroll
                for (int bj = 0; bj < 2; ++bj)
#pragma unroll
                    for (int n = 0; n < 2; ++n) { const int c = col0 + bj * 128 + n * 16; *(f32x4*)(dst + c) = *(const f32x4*)(src + c) + gv[bj][n] * acc[ai][bj][m][n]; } }
    }
};
struct EpiUp {
    static constexpr bool PERM = true, AFTER_DRAIN = false;
    bf16_t* O; int ldc;
    static __device__ __forceinline__ bool swapped(const Unit&) { return false; }
    __device__ __forceinline__ void operator()(const f32x4 (&acc)[2][2][4][2], const Unit& u, int wr, int wc, int fr, int fq) const {
        const int row0 = u.pm * 256 + wr * 64 + fr, col0 = u.pn * 256 + wc * 32 + 8 * fq;
#pragma unroll
        for (int ai = 0; ai < 2; ++ai)
#pragma unroll
            for (int m = 0; m < 4; ++m) { bf16_t* rowp = O + (size_t)(row0 + ai * 128 + m * 16) * ldc + col0;
#pragma unroll
                for (int bj = 0; bj < 2; ++bj) { f32x4 v0 = acc[ai][bj][m][0], v1 = acc[ai][bj][m][1];
#pragma unroll
                    for (int e = 0; e < 4; ++e) { const float a = fmaxf(v0[e], 0.f), b = fmaxf(v1[e], 0.f); v0[e] = a * a; v1[e] = b * b; }
                    u32x4 w; w.x = cvtpk(v0[0], v0[1]); w.y = cvtpk(v0[2], v0[3]); w.z = cvtpk(v1[0], v1[1]); w.w = cvtpk(v1[2], v1[3]);
                    *(u32x4*)(rowp + bj * 128) = w; } }
    }
};
template <class Epi, class Sched, bool ALIGN_EPI = false, bool SP2 = false>
__device__ __forceinline__ void gemm_phase(PG8_LAS unsigned char* lds, const Gemm g, const Sched& S, const Epi& E, int wave_s) {
    int tid_l; asm volatile("v_mbcnt_lo_u32_b32 %0, -1, 0\n\tv_mbcnt_hi_u32_b32 %0, -1, %0" : "=v"(tid_l)); tid_l += wave_s * 64;
    const int tid = tid_l, wid = __builtin_amdgcn_readfirstlane(tid >> 6), lane = tid & 63, wr = wid >> 2, wc = wid & 3, fr = lane & 15, fq = lane >> 4;
    const int K = g.K, nt = K / BK;
    unsigned voffA[2], voffB[2];
#pragma unroll
    for (int i = 0; i < 2; ++i) { int R, C; stage_rc(tid * 16 + i * 8192, R, C); const int Rb = Epi::PERM ? ((R & ~31) + perm32(R & 31)) : R;
        voffA[i] = (unsigned)(R * K + C) * 2u; voffB[i] = (unsigned)(Rb * K + C) * 2u; }
    const size_t kstep = (size_t)(BK * 2);
    const size_t hstep = (size_t)HALF * K * 2;
    const size_t tstep = 2 * hstep;
    const unsigned ldsw = (unsigned)wid * 1024u;
    const int aoff = lds_byte(wr * 64 + fr, fq * 8), boff = lds_byte(wc * 32 + fr, fq * 8);
#define PG8_SA(b, h) (((b) * 2 + (h)) * HTB)
#define PG8_SB(b, h) ((4 + (b) * 2 + (h)) * HTB)
#define PG8_STAGE(bufoff, gbase, voff) do { _Pragma("unroll") for (int _i = 0; _i < 2; ++_i) \
        __builtin_amdgcn_global_load_lds((const unsigned*)((const char*)(gbase) + (voff)[_i]), (PG8_LAS unsigned*)(lds + (bufoff) + ldsw + _i * 8192), 16, 0, 0); } while (0)
#define PG8_LDA(dst, b, h) do { _Pragma("unroll") for (int m = 0; m < 4; ++m) _Pragma("unroll") for (int k = 0; k < 2; ++k) dst[m][k] = *(const PG8_LAS bf16x8*)(lds + PG8_SA(b, h) + aoff + m * 2048 + k * 1024); } while (0)
#define PG8_LDB(dst, b, h) do { _Pragma("unroll") for (int n = 0; n < 2; ++n) _Pragma("unroll") for (int k = 0; k < 2; ++k) dst[n][k] = *(const PG8_LAS bf16x8*)(lds + PG8_SB(b, h) + boff + n * 2048 + k * 1024); } while (0)
#define PG8_MMA(ai, bj, At, Bt) do { __builtin_amdgcn_s_setprio(1); _Pragma("unroll") for (int m = 0; m < 4; ++m) _Pragma("unroll") for (int n = 0; n < 2; ++n) _Pragma("unroll") for (int k = 0; k < 2; ++k) \
        acc[ai][bj][m][n] = __builtin_amdgcn_mfma_f32_16x16x32_bf16(Bt[n][k], At[m][k], acc[ai][bj][m][n], 0, 0, 0); __builtin_amdgcn_s_setprio(0); } while (0)
#define PG8_WAIT_V(n) asm volatile("s_waitcnt vmcnt(" #n ")" ::: "memory")
#define PG8_WAIT_L(n) asm volatile("s_waitcnt lgkmcnt(" #n ")" ::: "memory")
#define PG8_BAR __builtin_amdgcn_s_barrier()
#define PG8_SCHED __builtin_amdgcn_sched_barrier(0)
    Unit cur, nxt; int ui = 0;
    if (!S.next(0, cur)) return;
    f32x4 acc[2][2][4][2];
#pragma unroll
    for (int a = 0; a < 2; ++a)
#pragma unroll
        for (int b = 0; b < 2; ++b)
#pragma unroll
            for (int m = 0; m < 4; ++m)
#pragma unroll
                for (int n = 0; n < 2; ++n) acc[a][b][m][n] = (f32x4){0.f, 0.f, 0.f, 0.f};
    bf16x8 At[4][2], B0[2][2], B1[2][2];
    const char* cA = (const char*)g.A + (size_t)cur.pm * tstep; const char* cB = (const char*)g.Bt + (size_t)cur.pn * tstep;
    if (Epi::swapped(cur)) { const char* t_ = cA; cA = cB; cB = t_; }
    S.a_ready(cur);
    if constexpr (SP2) {
        PG8_STAGE(PG8_SB(0, 0), cB, voffB); PG8_STAGE(PG8_SB(0, 1), cB + hstep, voffB); PG8_STAGE(PG8_SA(0, 0), cA, voffA); PG8_STAGE(PG8_SA(0, 1), cA + hstep, voffA);
        if (wr == 1) PG8_BAR;
        PG8_WAIT_V(2); PG8_BAR;
        PG8_STAGE(PG8_SB(1, 0), cB + kstep, voffB); PG8_STAGE(PG8_SA(1, 0), cA + kstep, voffA); PG8_STAGE(PG8_SB(1, 1), cB + hstep + kstep, voffB);
        PG8_WAIT_V(6); PG8_BAR;
    } else {
        PG8_STAGE(PG8_SB(0, 0), cB, voffB); PG8_STAGE(PG8_SA(0, 0), cA, voffA); PG8_STAGE(PG8_SB(0, 1), cB + hstep, voffB); PG8_STAGE(PG8_SA(0, 1), cA + hstep, voffA);
        if (wr == 1) PG8_BAR;
        PG8_WAIT_V(4); PG8_BAR;
        PG8_STAGE(PG8_SB(1, 0), cB + kstep, voffB); PG8_STAGE(PG8_SA(1, 0), cA + kstep, voffA); PG8_STAGE(PG8_SB(1, 1), cB + hstep + kstep, voffB);
        PG8_WAIT_V(6); PG8_BAR;
    }
    for (;;) {
        const bool has_next = S.next(ui + 1, nxt);
        const char* nA = has_next ? (const char*)g.A + (size_t)nxt.pm * tstep : cA; const char* nB = has_next ? (const char*)g.Bt + (size_t)nxt.pn * tstep : cB;
        if (has_next && Epi::swapped(nxt)) { const char* t_ = nA; nA = nB; nB = t_; }
        for (int t = 0; t < nt; t += 2) {
            const bool last = (t == nt - 2);
            const char* a1 = cA + (size_t)(t + 1) * kstep;
            const char* a2 = last ? nA : cA + (size_t)(t + 2) * kstep; const char* b2 = last ? nB : cB + (size_t)(t + 2) * kstep;
            const char* a3 = a2 + kstep; const char* b3 = b2 + kstep;
            if (last && has_next) S.a_ready(nxt);
            if constexpr (SP2) {
            PG8_LDB(B0, 0, 0); PG8_LDB(B1, 0, 1); PG8_SCHED; PG8_LDA(At, 0, 0); PG8_STAGE(PG8_SA(1, 1), a1 + hstep, voffA);
            PG8_WAIT_V(8); PG8_WAIT_L(0); PG8_BAR; PG8_MMA(0, 0, At, B0); PG8_MMA(0, 1, At, B1); PG8_BAR; PG8_SCHED;
            PG8_LDA(At, 0, 1); PG8_STAGE(PG8_SB(0, 0), b2, voffB); PG8_STAGE(PG8_SB(0, 1), b2 + hstep, voffB); PG8_STAGE(PG8_SA(0, 0), a2, voffA);
            PG8_WAIT_V(8); PG8_WAIT_L(0); PG8_BAR; PG8_MMA(1, 0, At, B0); PG8_MMA(1, 1, At, B1); PG8_BAR; PG8_SCHED;
            PG8_LDB(B0, 1, 0); PG8_LDB(B1, 1, 1); PG8_SCHED; PG8_LDA(At, 1, 0); PG8_STAGE(PG8_SA(0, 1), a2 + hstep, voffA);
            PG8_WAIT_V(8); PG8_WAIT_L(0); PG8_BAR; PG8_MMA(0, 0, At, B0); PG8_MMA(0, 1, At, B1); PG8_BAR; PG8_SCHED;
            PG8_LDA(At, 1, 1); PG8_STAGE(PG8_SB(1, 0), b3, voffB); PG8_STAGE(PG8_SB(1, 1), b3 + hstep, voffB); PG8_STAGE(PG8_SA(1, 0), a3, voffA);
            PG8_WAIT_V(8); PG8_WAIT_L(0); PG8_BAR; PG8_MMA(1, 0, At, B0); PG8_MMA(1, 1, At, B1); PG8_BAR; PG8_SCHED;
            } else {
            PG8_LDB(B0, 0, 0); PG8_SCHED; PG8_LDA(At, 0, 0); PG8_STAGE(PG8_SA(1, 1), a1 + hstep, voffA);
            PG8_WAIT_L(8); PG8_BAR; PG8_WAIT_L(0); PG8_MMA(0, 0, At, B0); PG8_BAR; PG8_SCHED;
            PG8_LDB(B1, 0, 1); PG8_STAGE(PG8_SB(0, 0), b2, voffB);
            PG8_BAR; PG8_WAIT_L(0); PG8_MMA(0, 1, At, B1); PG8_BAR;
            PG8_LDA(At, 0, 1); PG8_STAGE(PG8_SA(0, 0), a2, voffA);
            PG8_BAR; PG8_WAIT_L(0); PG8_MMA(1, 0, At, B0); PG8_BAR; PG8_SCHED;
            PG8_STAGE(PG8_SB(0, 1), b2 + hstep, voffB);
            PG8_WAIT_V(6); PG8_BAR; PG8_MMA(1, 1, At, B1); PG8_BAR;
            PG8_LDB(B0, 1, 0); PG8_SCHED; PG8_LDA(At, 1, 0); PG8_STAGE(PG8_SA(0, 1), a2 + hstep, voffA);
            PG8_WAIT_L(8); PG8_BAR; PG8_WAIT_L(0); PG8_MMA(0, 0, At, B0); PG8_BAR; PG8_SCHED;
            PG8_LDB(B1, 1, 1); PG8_STAGE(PG8_SB(1, 0), b3, voffB);
            PG8_BAR; PG8_WAIT_L(0); PG8_MMA(0, 1, At, B1); PG8_BAR;
            PG8_LDA(At, 1, 1); PG8_STAGE(PG8_SA(1, 0), a3, voffA);
            PG8_BAR; PG8_WAIT_L(0); PG8_MMA(1, 0, At, B0); PG8_BAR; PG8_SCHED;
            PG8_STAGE(PG8_SB(1, 1), b3 + hstep, voffB);
            PG8_WAIT_V(6); PG8_BAR; PG8_MMA(1, 1, At, B1); PG8_BAR;
            }
        }
        if constexpr (ALIGN_EPI) { if (wr == 0) PG8_BAR; }
        if constexpr (!Epi::AFTER_DRAIN) { E(acc, cur, wr, wc, fr, fq); S.done(cur); }
        if (!has_next) break;
#pragma unroll
        for (int a = 0; a < 2; ++a)
#pragma unroll
            for (int b = 0; b < 2; ++b)
#pragma unroll
                for (int m = 0; m < 4; ++m)
#pragma unroll
                    for (int n = 0; n < 2; ++n) acc[a][b][m][n] = (f32x4){0.f, 0.f, 0.f, 0.f};
        cur = nxt; cA = nA; cB = nB; ++ui;
        if constexpr (ALIGN_EPI) { if (wr == 1) PG8_BAR; }
    }
    PG8_WAIT_V(0);
    if constexpr (!ALIGN_EPI) { if (wr == 0) PG8_BAR; }
    PG8_BAR;
    if constexpr (Epi::AFTER_DRAIN) { E.fused(acc, cur, wr, wc, fr, fq, lds, wid, lane); S.done(cur); }
#undef PG8_SA
#undef PG8_SB
#undef PG8_STAGE
#undef PG8_LDA
#undef PG8_LDB
#undef PG8_MMA
#undef PG8_WAIT_V
#undef PG8_WAIT_L
#undef PG8_BAR
#undef PG8_SCHED
}
}

#define LAS __attribute__((address_space(3)))
typedef unsigned short bf16_t;
typedef short bf16x8 __attribute__((ext_vector_type(8)));
typedef float f32x4 __attribute__((ext_vector_type(4)));
typedef float f32x16 __attribute__((ext_vector_type(16)));
typedef unsigned u32x4 __attribute__((ext_vector_type(4)));
typedef unsigned u32x2 __attribute__((ext_vector_type(2)));
using pg8::cvtpk;

constexpr int NTOK = 10240, NCTX = 8192, DM = 1024, INW = 2816, DFF = 4096, NLAYER = 4;
constexpr int LDS_BYTES = 147456;
constexpr size_t MiB = 1u << 20;
constexpr size_t WS_MOD = 1 * MiB, WS_ROPE = WS_MOD + 512 * 1024, WS_WIN = 2 * MiB, WS_WOUT = 24 * MiB, WS_WUP = 32 * MiB, WS_WDN = 64 * MiB, WS_H = 96 * MiB,
                 WS_KL = 116 * MiB, WS_VTL = 128 * MiB, WS_VTC = 140 * MiB, WS_VST = 148 * MiB, WS_MIX = 154 * MiB, WS_P = 176 * MiB, WS_A = 154 * MiB, WS_END = 234 * MiB;
constexpr size_t WIN_L = (size_t)INW * DM, WOUT_L = (size_t)DM * DM, WUP_L = (size_t)DFF * DM, WDN_L = (size_t)DM * DFF;
constexpr size_t KL_L = (size_t)2 * 1536 * 512, VTL_L = (size_t)2 * 512 * 1536;

struct Params {
    const float *x_prompt, *x_sample, *cache_k, *cache_v, *c, *c_ctx, *w_mod, *b_mod, *norm_mix, *norm_mlp, *w_in, *lam_q1, *lam_k1, *lam_q2, *lam_k2, *subln,
                *conv_w, *conv_b, *w_s, *b_s, *w_out, *w_up, *w_down, *norm_final;
    float* out; unsigned char* ws;
    long long ph_lo, ph_hi;
};

__device__ __forceinline__ float wave_sum(float v) {
#pragma unroll
    for (int o = 1; o < 64; o <<= 1) v += __shfl_xor(v, o);
    return v;
}
__device__ __forceinline__ float xhalf_max(float v) { auto rr = __builtin_amdgcn_permlane32_swap(__float_as_uint(v), __float_as_uint(v), false, false); return fmaxf(__uint_as_float(rr[0]), __uint_as_float(rr[1])); }
__device__ __forceinline__ float xhalf_sum(float v) { auto rr = __builtin_amdgcn_permlane32_swap(__float_as_uint(v), __float_as_uint(v), false, false); return __uint_as_float(rr[0]) + __uint_as_float(rr[1]); }
__device__ __forceinline__ float bf2f(unsigned short b) { return __uint_as_float((unsigned)b << 16); }

__device__ __forceinline__ void transpose_item(const float* W, int N, bf16_t* WT, int ldo, LAS float* scr, int item, int lane) {
    const int nblk = N / 64, kb = item / nblk, nb = item % nblk, k0 = 64 * kb, n0 = 64 * nb;
    const int lr = lane >> 4, lc = (lane & 15) * 4;
    f32x4 v[16];
#pragma unroll
    for (int i = 0; i < 16; ++i) v[i] = __builtin_nontemporal_load((const f32x4*)(W + (size_t)(k0 + 4 * i + lr) * N + n0 + lc));
#pragma unroll
    for (int i = 0; i < 16; ++i) { LAS float* d = scr + (4 * i + lr) * 65 + lc; d[0] = v[i][0]; d[1] = v[i][1]; d[2] = v[i][2]; d[3] = v[i][3]; }
    asm volatile("s_waitcnt lgkmcnt(0)" ::: "memory");
    const int c = lane & 7;
#pragma unroll
    for (int j = 0; j < 8; ++j) { const int n = (lane >> 3) + 8 * j; const LAS float* s = scr + (8 * c) * 65 + n;
        u32x4 o; o.x = cvtpk(s[0 * 65], s[1 * 65]); o.y = cvtpk(s[2 * 65], s[3 * 65]); o.z = cvtpk(s[4 * 65], s[5 * 65]); o.w = cvtpk(s[6 * 65], s[7 * 65]);
        *(u32x4*)(WT + (size_t)(n0 + n) * ldo + k0 + 8 * c) = o; }
    asm volatile("s_waitcnt lgkmcnt(0)" ::: "memory");
}
constexpr int STASH_OFF = 144000;
__device__ __forceinline__ const float* ld_param(LAS unsigned char* lds, int i) {
    unsigned off = STASH_OFF; asm volatile("" : "+s"(off));
    volatile LAS unsigned* s = (volatile LAS unsigned*)(lds + off) + 2 * i; unsigned lo = s[0], hi = s[1];
    lo = __builtin_amdgcn_readfirstlane(lo); hi = __builtin_amdgcn_readfirstlane(hi);
    return (const float*)(((unsigned long long)hi << 32) | (unsigned long long)lo);
}
__device__ __forceinline__ Params load_params(LAS unsigned char* lds, unsigned char* ws, float* out) {
    Params q; q.x_prompt = ld_param(lds, 0); q.x_sample = ld_param(lds, 1); q.cache_k = ld_param(lds, 2); q.cache_v = ld_param(lds, 3); q.c = ld_param(lds, 4); q.c_ctx = ld_param(lds, 5);
    q.w_mod = ld_param(lds, 6); q.b_mod = ld_param(lds, 7); q.norm_mix = ld_param(lds, 8); q.norm_mlp = ld_param(lds, 9); q.w_in = ld_param(lds, 10); q.lam_q1 = ld_param(lds, 11);
    q.lam_k1 = ld_param(lds, 12); q.lam_q2 = ld_param(lds, 13); q.lam_k2 = ld_param(lds, 14); q.subln = ld_param(lds, 15); q.conv_w = ld_param(lds, 16); q.conv_b = ld_param(lds, 17);
    q.w_s = ld_param(lds, 18); q.b_s = ld_param(lds, 19); q.w_out = ld_param(lds, 20); q.w_up = ld_param(lds, 21); q.w_down = ld_param(lds, 22); q.norm_final = ld_param(lds, 23);
    q.out = out; q.ws = ws; q.ph_lo = 0; q.ph_hi = 0; return q;
}
__device__ __forceinline__ void prologue_phase(const Params& p, LAS unsigned char* lds, int G, int bid, int tid, int wave, int lane) {
    unsigned char* ws = p.ws;
    LAS float* scr = (LAS float*)(lds + wave * 16640);
    LAS float* sc = (LAS float*)(lds);
    LAS float* red = (LAS float*)(lds + 12288);
    float* mod = (float*)(ws + WS_MOD);
    for (int i = tid; i < 3072; i += 512) { const int s = i >> 10, k = i & 1023; const float v = s == 0 ? p.c_ctx[k] : p.c[(s - 1) * 1024 + k]; sc[i] = v / (1.f + __expf(-v)); }
    __syncthreads();
    for (int item = bid; item < 192; item += G) {
        const int d = item / 48, cgp = item % 48; const float* W = p.w_mod + (size_t)d * 1024 * 6144 + cgp * 128 + 2 * lane;
        float a00 = 0.f, a01 = 0.f, a10 = 0.f, a11 = 0.f, a20 = 0.f, a21 = 0.f; const int k0 = wave * 128;
#pragma unroll 16
        for (int kk = 0; kk < 128; ++kk) { const int k = k0 + kk; const float2 w = *(const float2*)(W + (size_t)k * 6144); const float s0 = sc[k], s1 = sc[1024 + k], s2 = sc[2048 + k];
            a00 += s0 * w.x; a01 += s0 * w.y; a10 += s1 * w.x; a11 += s1 * w.y; a20 += s2 * w.x; a21 += s2 * w.y; }
        red[(wave * 3 + 0) * 128 + 2 * lane] = a00; red[(wave * 3 + 0) * 128 + 2 * lane + 1] = a01;
        red[(wave * 3 + 1) * 128 + 2 * lane] = a10; red[(wave * 3 + 1) * 128 + 2 * lane + 1] = a11;
        red[(wave * 3 + 2) * 128 + 2 * lane] = a20; red[(wave * 3 + 2) * 128 + 2 * lane + 1] = a21;
        __syncthreads();
        if (tid < 384) { const int s = tid >> 7, col = tid & 127; float sum = p.b_mod[d * 6144 + cgp * 128 + col];
#pragma unroll
            for (int w = 0; w < 8; ++w) sum += red[(w * 3 + s) * 128 + col];
            mod[(d * 3 + s) * 6144 + cgp * 128 + col] = sum; }
        __syncthreads();
    }
    { const int gt = bid * 512 + tid; if (gt < 1024) { const int pos = gt >> 4, i = gt & 15; const float inv = exp2f(-(float)i * (13.287712379549449f / 16.f)); const float ang = (float)pos * inv;
        float* rc = (float*)(ws + WS_ROPE); rc[gt] = cosf(ang); rc[1024 + gt] = sinf(ang); } }
    const int vw = wave * G + bid, NVW = 8 * G;
    constexpr int I_IN = 16 * 44, I_OUT = 16 * 16, I_UP = 16 * 64, I_DN = 64 * 16, I_L = I_IN + I_OUT + I_UP + I_DN, I_CV = 8 * 8, I_ALL = 4 * I_L + 8 * I_CV;
    for (int it = vw; it < I_ALL; it += NVW) {
        if (it < 4 * I_L) { const int d = it / I_L; int r = it % I_L;
            if (r < I_IN) { transpose_item(p.w_in + (size_t)d * WIN_L, INW, (bf16_t*)(ws + WS_WIN) + (size_t)d * WIN_L, DM, scr, r, lane); continue; } r -= I_IN;
            if (r < I_OUT) { transpose_item(p.w_out + (size_t)d * WOUT_L, DM, (bf16_t*)(ws + WS_WOUT) + (size_t)d * WOUT_L, DM, scr, r, lane); continue; } r -= I_OUT;
            if (r < I_UP) { transpose_item(p.w_up + (size_t)d * WUP_L, DFF, (bf16_t*)(ws + WS_WUP) + (size_t)d * WUP_L, DM, scr, r, lane); continue; } r -= I_UP;
            transpose_item(p.w_down + (size_t)d * WDN_L, DM, (bf16_t*)(ws + WS_WDN) + (size_t)d * WDN_L, DFF, scr, r, lane);
        } else { const int r = it - 4 * I_L, bd = r / I_CV, b = bd >> 2, d = bd & 3;
            transpose_item(p.cache_v + (size_t)bd * 512 * 512, 512, (bf16_t*)(ws + WS_VTL) + (size_t)d * VTL_L + (size_t)b * 512 * 1536, 1536, scr, r % I_CV, lane); }
    }
    for (int i = bid * 512 + tid; i < 2 * 4 * 512 * 64; i += G * 512) { const int c8 = (i & 63) * 8, key = (i >> 6) & 511, bd = i >> 15, b = bd >> 2, d = bd & 3;
        const float* src = p.cache_k + ((size_t)bd * 512 + key) * 512 + c8; const f32x4 v0 = *(const f32x4*)src, v1 = *(const f32x4*)(src + 4);
        u32x4 o; o.x = cvtpk(v0[0], v0[1]); o.y = cvtpk(v0[2], v0[3]); o.z = cvtpk(v1[0], v1[1]); o.w = cvtpk(v1[2], v1[3]);
        *(u32x4*)((bf16_t*)(ws + WS_KL) + (size_t)d * KL_L + ((size_t)b * 1536 + key) * 512 + c8) = o; }
}

__device__ __forceinline__ void norm_phase(const Params& p, int layer, int which, int G, int bid, int wave, int lane) {
    const float* mod = (const float*)(p.ws + WS_MOD); const float* xbuf = p.out; bf16_t* H = (bf16_t*)(p.ws + WS_H);
    const float* g = (which ? p.norm_mlp : p.norm_mix) + layer * 1024;
    const bool first = (layer == 0 && which == 0);
    for (int row = wave * G + bid; row < NTOK; row += 8 * G) {
        const float* xr = first ? (row < NCTX ? p.x_prompt + (size_t)row * 1024 : p.x_sample + (size_t)(row - NCTX) * 1024) : xbuf + (size_t)row * 1024;
        const int s = row < NCTX ? 0 : 1 + ((row - NCTX) >> 10);
        const float* sh = mod + (size_t)((layer * 3 + s) * 6 + (which ? 3 : 0)) * 1024; const float* scl = sh + 1024;
        f32x4 v[4]; float ss = 0.f;
#pragma unroll
        for (int j = 0; j < 4; ++j) { v[j] = *(const f32x4*)(xr + 4 * lane + 256 * j); ss += (v[j][0] * v[j][0] + v[j][1] * v[j][1]) + (v[j][2] * v[j][2] + v[j][3] * v[j][3]); }
        const float rstd = rsqrtf(wave_sum(ss) * (1.f / 1024.f) + 1e-6f);
#pragma unroll
        for (int j = 0; j < 4; ++j) { const int c = 4 * lane + 256 * j; const f32x4 gg = *(const f32x4*)(g + c), a = *(const f32x4*)(scl + c), b = *(const f32x4*)(sh + c);
            const f32x4 y = v[j] * rstd * gg * (a + 1.f) + b; u32x2 w; w.x = cvtpk(y[0], y[1]); w.y = cvtpk(y[2], y[3]); *(u32x2*)(H + (size_t)row * 1024 + c) = w; }
    }
}
__device__ __forceinline__ void final_norm_phase(const Params& p, int G, int bid, int wave, int lane) {
    for (int row = wave * G + bid; row < NTOK; row += 8 * G) {
        float* xr = p.out + (size_t)row * 1024; f32x4 v[4]; float ss = 0.f;
#pragma unroll
        for (int j = 0; j < 4; ++j) { v[j] = *(const f32x4*)(xr + 4 * lane + 256 * j); ss += (v[j][0] * v[j][0] + v[j][1] * v[j][1]) + (v[j][2] * v[j][2] + v[j][3] * v[j][3]); }
        const float rstd = rsqrtf(wave_sum(ss) * (1.f / 1024.f) + 1e-6f);
#pragma unroll
        for (int j = 0; j < 4; ++j) { const int c = 4 * lane + 256 * j; *(f32x4*)(xr + c) = v[j] * rstd * *(const f32x4*)(p.norm_final + c); }
    }
}

struct AttnState { f32x16 O0[4], O1[4]; float m0, m1, l0, l1; };
__device__ __forceinline__ void sm_step(f32x16& S, float& m, float& l, f32x16 (&O)[4], bf16x8 (&P)[2]) {
    float mx = fmaxf(S[0], S[1]);
#pragma unroll
    for (int r = 2; r < 16; ++r) mx = fmaxf(mx, S[r]);
    mx = xhalf_max(mx);
    const float mn = fmaxf(m, mx);
    if (__any(mn > m)) { const float al = __builtin_amdgcn_exp2f(m - mn); l *= al;
#pragma unroll
        for (int b = 0; b < 4; ++b)
#pragma unroll
            for (int r = 0; r < 16; ++r) O[b][r] *= al; }
    m = mn; float ps = 0.f;
#pragma unroll
    for (int r = 0; r < 16; ++r) { S[r] = __builtin_amdgcn_exp2f(S[r] - mn); ps += S[r]; }
    l += ps;
#pragma unroll
    for (int s = 0; s < 2; ++s) { u32x4 w; w.x = cvtpk(S[8 * s], S[8 * s + 1]); w.y = cvtpk(S[8 * s + 2], S[8 * s + 3]); w.z = cvtpk(S[8 * s + 4], S[8 * s + 5]); w.w = cvtpk(S[8 * s + 6], S[8 * s + 7]); P[s] = __builtin_bit_cast(bf16x8, w); }
}
__device__ __forceinline__ void attn_tiles(AttnState& st, const bf16_t* Q, int qpitch, const bf16_t* K, int kpitch, const bf16_t* Vt, int vpitch, int ntiles, LAS unsigned char* qlds, int lane) {
    const int r32 = lane & 31, hi = lane >> 5;
    LAS bf16x8* qs = (LAS bf16x8*)qlds + lane;
#pragma unroll
    for (int c = 0; c < 2; ++c)
#pragma unroll
        for (int d0 = 0; d0 < 4; ++d0) qs[(c * 4 + d0) * 64] = *(const bf16x8*)(Q + (size_t)r32 * qpitch + c * 64 + d0 * 16 + hi * 8);
#pragma unroll
    for (int b = 0; b < 4; ++b) { st.O0[b] = f32x16{}; st.O1[b] = f32x16{}; }
    st.m0 = -1e30f; st.m1 = -1e30f; st.l0 = 0.f; st.l1 = 0.f;
    const int pr = (r32 & ~12) | ((r32 & 4) << 1) | ((r32 & 8) >> 1);
    const bf16_t* kp = K + (size_t)pr * kpitch + hi * 8; const bf16_t* vp = Vt + (size_t)r32 * vpitch + hi * 8;
    for (int t = 0; t < ntiles; ++t) {
        bf16x8 P0[2], P1[2];
        { bf16x8 kf[4];
#pragma unroll
          for (int d0 = 0; d0 < 4; ++d0) kf[d0] = *(const bf16x8*)(kp + d0 * 16);
          f32x16 S = f32x16{};
#pragma unroll
          for (int d0 = 0; d0 < 4; ++d0) S = __builtin_amdgcn_mfma_f32_32x32x16_bf16(kf[d0], qs[d0 * 64], S, 0, 0, 0);
          sm_step(S, st.m0, st.l0, st.O0, P0); }
        { bf16x8 kf[4];
#pragma unroll
          for (int d0 = 0; d0 < 4; ++d0) kf[d0] = *(const bf16x8*)(kp + 64 + d0 * 16);
          f32x16 S = f32x16{};
#pragma unroll
          for (int d0 = 0; d0 < 4; ++d0) S = __builtin_amdgcn_mfma_f32_32x32x16_bf16(kf[d0], qs[(4 + d0) * 64], S, 0, 0, 0);
          sm_step(S, st.m1, st.l1, st.O1, P1); }
#pragma unroll
        for (int s = 0; s < 2; ++s)
#pragma unroll
            for (int b = 0; b < 4; ++b) { const bf16x8 vf = *(const bf16x8*)(vp + (size_t)(b * 32) * vpitch + s * 16);
                st.O0[b] = __builtin_amdgcn_mfma_f32_32x32x16_bf16(vf, P0[s], st.O0[b], 0, 0, 0);
                st.O1[b] = __builtin_amdgcn_mfma_f32_32x32x16_bf16(vf, P1[s], st.O1[b], 0, 0, 0); }
        kp += (size_t)32 * kpitch; vp += 32;
    }
}
__device__ __forceinline__ void attn_finish_single(AttnState& st, float lam, const float* subln, float oscale, bf16_t* out, int lane) {
    const int r32 = lane & 31, hi = lane >> 5;
    const float i0 = 1.f / xhalf_sum(st.l0), i1 = lam / xhalf_sum(st.l1); float ss = 0.f;
#pragma unroll
    for (int b = 0; b < 4; ++b)
#pragma unroll
        for (int r = 0; r < 16; ++r) { const float R = st.O0[b][r] * i0 - st.O1[b][r] * i1; st.O0[b][r] = R; ss += R * R; }
    const float rstd = rsqrtf(xhalf_sum(ss) * (1.f / 128.f) + 1e-6f) * oscale;
#pragma unroll
    for (int b = 0; b < 4; ++b)
#pragma unroll
        for (int g = 0; g < 4; ++g) { const int dv = 32 * b + 8 * g + 4 * hi; const f32x4 sg = *(const f32x4*)(subln + dv);
            u32x2 w; w.x = cvtpk(st.O0[b][4 * g] * rstd * sg[0], st.O0[b][4 * g + 1] * rstd * sg[1]); w.y = cvtpk(st.O0[b][4 * g + 2] * rstd * sg[2], st.O0[b][4 * g + 3] * rstd * sg[3]);
            *(u32x2*)(out + (size_t)r32 * 1024 + dv) = w; }
}
__device__ __forceinline__ void attn_finish_split(AttnState& st, float lam, const float* subln, float oscale, bf16_t* out, LAS unsigned char* lds, int wave, int lane) {
    const int r32 = lane & 31, hi = lane >> 5;
    LAS float* red = (LAS float*)lds;
    LAS float* stt = (LAS float*)(lds + 131072);
    LAS float* ssq = stt + 1024;
    const float l0 = xhalf_sum(st.l0), l1 = xhalf_sum(st.l1);
    if (hi == 0) { stt[(wave * 4 + 0) * 32 + r32] = st.m0; stt[(wave * 4 + 1) * 32 + r32] = l0; stt[(wave * 4 + 2) * 32 + r32] = st.m1; stt[(wave * 4 + 3) * 32 + r32] = l1; }
    __syncthreads();
    float M0 = -1e30f, M1 = -1e30f;
#pragma unroll
    for (int w = 0; w < 8; ++w) { M0 = fmaxf(M0, stt[(w * 4 + 0) * 32 + r32]); M1 = fmaxf(M1, stt[(w * 4 + 2) * 32 + r32]); }
    float L0 = 0.f, L1 = 0.f;
#pragma unroll
    for (int w = 0; w < 8; ++w) { L0 += stt[(w * 4 + 1) * 32 + r32] * __builtin_amdgcn_exp2f(stt[(w * 4 + 0) * 32 + r32] - M0); L1 += stt[(w * 4 + 3) * 32 + r32] * __builtin_amdgcn_exp2f(stt[(w * 4 + 2) * 32 + r32] - M1); }
    const float f0 = __builtin_amdgcn_exp2f(st.m0 - M0) / L0, f1 = lam * __builtin_amdgcn_exp2f(st.m1 - M1) / L1;
#pragma unroll
    for (int b = 0; b < 4; ++b)
#pragma unroll
        for (int r = 0; r < 16; ++r) { red[(wave * 64 + b * 16 + r) * 64 + lane] = st.O0[b][r] * f0 - st.O1[b][r] * f1; if ((r & 3) == 3) asm volatile("" ::: "memory"); }
    __syncthreads();
    float R[8]; float ss = 0.f;
#pragma unroll
    for (int j = 0; j < 8; ++j) { float sum = 0.f;
#pragma unroll
        for (int w = 0; w < 8; ++w) sum += red[(w * 64 + wave * 8 + j) * 64 + lane];
        R[j] = sum; ss += sum * sum; }
    ss = xhalf_sum(ss);
    if (hi == 0) ssq[wave * 32 + r32] = ss;
    __syncthreads();
    float tot = 0.f;
#pragma unroll
    for (int w = 0; w < 8; ++w) tot += ssq[w * 32 + r32];
    const float rstd = rsqrtf(tot * (1.f / 128.f) + 1e-6f) * oscale;
#pragma unroll
    for (int g = 0; g < 2; ++g) { const int dv = 32 * (wave >> 1) + 16 * (wave & 1) + 8 * g + 4 * hi; const f32x4 sg = *(const f32x4*)(subln + dv);
        u32x2 w; w.x = cvtpk(R[4 * g] * rstd * sg[0], R[4 * g + 1] * rstd * sg[1]); w.y = cvtpk(R[4 * g + 2] * rstd * sg[2], R[4 * g + 3] * rstd * sg[3]);
        *(u32x2*)(out + (size_t)r32 * 1024 + dv) = w; }
    __syncthreads();
}

__device__ __forceinline__ void mixer_phase(const Params& p, int layer, LAS unsigned char* lds, int G, int bid, int wave, int lane) {
    unsigned char* ws = p.ws;
    const bf16_t* P = (const bf16_t*)(ws + WS_P); bf16_t* MIX = (bf16_t*)(ws + WS_MIX);
    const bf16_t* KL = (const bf16_t*)(ws + WS_KL) + (size_t)layer * KL_L; const bf16_t* VtL = (const bf16_t*)(ws + WS_VTL) + (size_t)layer * VTL_L;
    const bf16_t* VtC = (const bf16_t*)(ws + WS_VTC); const bf16_t* VsT = (const bf16_t*)(ws + WS_VST);
    const float lam_init = 0.8f - 0.6f * __expf(-0.3f * (float)layer);
    const float s1 = wave_sum(p.lam_q1[layer * 64 + lane] * p.lam_k1[layer * 64 + lane]), s2 = wave_sum(p.lam_q2[layer * 64 + lane] * p.lam_k2[layer * 64 + lane]);
    const float lam = __expf(s1) - __expf(s2) + lam_init; const float oscale = 1.f - lam_init;
    const float* subln = p.subln + layer * 128;
    for (int it = bid; it < 256; it += G) {
        const int b = it >> 7, h = (it >> 5) & 3, qt = it & 31; const int tok0 = NCTX + b * 1024 + qt * 32;
        AttnState st;
        attn_tiles(st, P + (size_t)tok0 * INW + h * 128, INW, KL + ((size_t)b * 1536 + 192 * wave) * 512 + h * 128, 512, VtL + (size_t)((b * 4 + h) * 128) * 1536 + 192 * wave, 1536, 6, lds + wave * 8192, lane);
        attn_finish_split(st, lam, subln, oscale, MIX + (size_t)tok0 * 1024 + h * 128, lds, wave, lane);
    }
    if (wave < 4) {
        for (int it = wave * G + bid; it < 1024; it += 4 * G) {
            const int b = it >> 5, h = (it >> 3) & 3, qt = it & 7; const int tok0 = b * 256 + qt * 32;
            AttnState st;
            attn_tiles(st, P + (size_t)tok0 * INW + h * 128, INW, P + (size_t)(b * 256) * INW + 512 + h * 128, INW, VtC + (size_t)((b * 4 + h) * 128) * 256, 256, 8, lds + wave * 8192, lane);
            attn_finish_single(st, lam, subln, oscale, MIX + (size_t)tok0 * 1024 + h * 128, lane);
        }
    } else {
        const float* cw = p.conv_w + layer * 768; const float* cb = p.conv_b + layer * 256;
        for (int i = ((wave - 4) * G + bid) * 64 + lane; i < NTOK * 32; i += 4 * G * 64) {
            const int tok = i >> 5, c8 = (i & 31) * 8; const bf16_t* row = P + (size_t)tok * INW; const int sl = tok < NCTX ? 256 : 1024, pos = tok & (sl - 1);
            const u32x4 gb = *(const u32x4*)(row + 1536 + c8), gc1 = *(const u32x4*)(row + 1792 + c8), xi1 = *(const u32x4*)(row + 2048 + c8);
            u32x4 gc0 = {0u, 0u, 0u, 0u}, xi0 = gc0, gc2 = gc0, xi2 = gc0;
            if (pos > 0) { gc0 = *(const u32x4*)(row - INW + 1792 + c8); xi0 = *(const u32x4*)(row - INW + 2048 + c8); }
            if (pos < sl - 1) { gc2 = *(const u32x4*)(row + INW + 1792 + c8); xi2 = *(const u32x4*)(row + INW + 2048 + c8); }
            u32x4 o;
#pragma unroll
            for (int e = 0; e < 4; ++e) { float r2[2];
#pragma unroll
                for (int hh = 0; hh < 2; ++hh) { const int sh = hh * 16; const int ch = c8 + 2 * e + hh;
#define ex(w) __uint_as_float(((w) >> sh) << 16)
                    const float g0 = ex(gc0[e]) * ex(xi0[e]), g1 = ex(gc1[e]) * ex(xi1[e]), g2 = ex(gc2[e]) * ex(xi2[e]);
                    r2[hh] = ex(gb[e]) * (g0 * cw[ch] + g1 * cw[256 + ch] + g2 * cw[512 + ch] + cb[ch]); }
#undef ex
                o[e] = cvtpk(r2[0], r2[1]); }
            *(u32x4*)(MIX + (size_t)tok * 1024 + 512 + c8) = o;
        }
        const float* wsl = p.w_s + (size_t)layer * 4 * 128 * 128; const float* bsl = p.b_s + layer * 512;
        const int r32 = lane & 31, hi = lane >> 5;
        for (int it = (wave - 4) * G + bid; it < 80 * 32; it += 4 * G) {
            const int ch = it >> 5, g = (it >> 3) & 3, db = (it >> 2) & 1, pb = it & 3;
            const bf16_t* ap = VsT + (size_t)(g * 64 + db * 32 + r32) * NTOK + ch * 128 + hi * 8;
            const float* bp = wsl + (size_t)(g * 128 + pb * 32 + r32) * 128 + hi * 8;
            f32x16 D = f32x16{};
#pragma unroll
            for (int ks = 0; ks < 8; ++ks) { const bf16x8 a = *(const bf16x8*)(ap + ks * 16); const f32x4 b0 = *(const f32x4*)(bp + ks * 16), b1 = *(const f32x4*)(bp + ks * 16 + 4);
                u32x4 w; w.x = cvtpk(b0[0], b0[1]); w.y = cvtpk(b0[2], b0[3]); w.z = cvtpk(b1[0], b1[1]); w.w = cvtpk(b1[2], b1[3]);
                D = __builtin_amdgcn_mfma_f32_32x32x16_bf16(a, __builtin_bit_cast(bf16x8, w), D, 0, 0, 0); }
            const int tok = ch * 128 + pb * 32 + r32; const float bias = bsl[g * 128 + pb * 32 + r32];
#pragma unroll
            for (int q4 = 0; q4 < 4; ++q4) { const int d = g * 64 + db * 32 + 8 * q4 + 4 * hi; const u32x2 uu = *(const u32x2*)(P + (size_t)tok * INW + 2304 + d);
                u32x2 w; w.x = cvtpk(__uint_as_float(uu.x << 16) * (D[4 * q4] + bias), __uint_as_float(uu.x & 0xffff0000u) * (D[4 * q4 + 1] + bias));
                w.y = cvtpk(__uint_as_float(uu.y << 16) * (D[4 * q4 + 2] + bias), __uint_as_float(uu.y & 0xffff0000u) * (D[4 * q4 + 3] + bias));
                *(u32x2*)(MIX + (size_t)tok * 1024 + 768 + d) = w; }
        }
    }
}


#define XB_TMO      128
#define XB_XCNT(j)  (256  + 64 * (j))
#define XB_XSUB(j)  (1280 + 64 * (j))
#define XB_XGEN(j)  (2304 + 64 * (j))
#define XB_TOP      3328
#define XB_TOPGEN   3392
#define XCD_BAR_WORDS 3456
#define XB_SPIN_CAP (1u << 22)
__device__ __forceinline__ unsigned xb_ld(unsigned* p)              { return __hip_atomic_load(p, __ATOMIC_RELAXED, __HIP_MEMORY_SCOPE_AGENT); }
__device__ __forceinline__ unsigned xb_add(unsigned* p, unsigned v) { return __hip_atomic_fetch_add(p, v, __ATOMIC_RELAXED, __HIP_MEMORY_SCOPE_AGENT); }
__device__ __forceinline__ unsigned xb_xcc_id() { return (unsigned)__builtin_amdgcn_s_getreg((3 << 11) | 20) & 0xFu; }
#define XB_SPIN(cond, bar) do { unsigned _sp = 0; while (cond) { __builtin_amdgcn_s_sleep(1); \
    if ((++_sp & 255u) == 0u) { if (xb_ld(&(bar)[XB_TMO])) break; if (_sp > XB_SPIN_CAP) { atomicAdd(&(bar)[XB_TMO], 1u); break; } } } } while (0)
__device__ __forceinline__ void xcd_barrier_complete(unsigned* bar, unsigned x, unsigned G, unsigned& nloc, unsigned& nx) {
    unsigned sum, cnt, mine, sp = 0u;
    for (;;) {
        sum = 0u; cnt = 0u; mine = 0u;
#pragma unroll
        for (unsigned j = 0; j < 16; ++j) { const unsigned c = xb_ld(&bar[XB_XCNT(j)]); sum += c; cnt += (c > 0u) ? 1u : 0u; mine = (j == x) ? c : mine; }
        if (sum == G) break;
        __builtin_amdgcn_s_sleep(1);
        if ((++sp & 255u) == 0u) { if (xb_ld(&bar[XB_TMO])) break; if (sp > XB_SPIN_CAP) { atomicAdd(&bar[XB_TMO], 1u); break; } }
    }
    nloc = mine > 0u ? mine : 1u; nx = cnt > 0u ? cnt : 1u;
}
__device__ __forceinline__ void xcd_barrier(unsigned* bar, volatile LAS unsigned* st, bool leader, unsigned G) {
    asm volatile("s_waitcnt vmcnt(0)" ::: "memory");
    __syncthreads();
    if (leader) {
        __builtin_amdgcn_s_waitcnt(0);
        const unsigned x = xb_xcc_id();
        unsigned nloc = st[0], nx = st[1];
        if (nloc == 0u) { xcd_barrier_complete(bar, x, G, nloc, nx); st[0] = nloc; st[1] = nx; }
        const unsigned old = xb_add(&bar[XB_XSUB(x)], 1u);
        const unsigned gen = old / nloc;
        if (old + 1u == (gen + 1u) * nloc) {
            __builtin_amdgcn_fence(__ATOMIC_RELEASE, "agent");
            asm volatile("s_waitcnt vmcnt(0)" ::: "memory");
            const unsigned og = xb_add(&bar[XB_TOP], 1u);
            const unsigned tg = og / nx;
            if (og + 1u == (tg + 1u) * nx) xb_add(&bar[XB_TOPGEN], 1u);
            else XB_SPIN(xb_ld(&bar[XB_TOPGEN]) == tg, bar);
            __builtin_amdgcn_fence(__ATOMIC_ACQUIRE, "agent");
            xb_add(&bar[XB_XGEN(x)], 1u);
            asm volatile("s_waitcnt vmcnt(0)" ::: "memory");
        } else {
            XB_SPIN(xb_ld(&bar[XB_XGEN(x)]) == gen, bar);
            __builtin_amdgcn_fence(__ATOMIC_ACQUIRE, "agent");
            asm volatile("s_waitcnt vmcnt(0)" ::: "memory");
        }
    }
    __syncthreads();
}
__global__ void __launch_bounds__(512, 2) mega(Params p) {
    extern __shared__ __attribute__((aligned(16))) unsigned char lds_raw[];
    LAS unsigned char* lds = (LAS unsigned char*)lds_raw;
    const int wave_k = __builtin_amdgcn_readfirstlane(threadIdx.x >> 6), G_k = gridDim.x, bid_k = blockIdx.x;
    unsigned char* ws_k = p.ws; float* out_k = p.out;
    const int lo = (int)p.ph_lo, hi = (int)p.ph_hi; int ph = 0;
    if (threadIdx.x == 0) { LAS unsigned long long* st = (LAS unsigned long long*)(lds + STASH_OFF);
        st[0] = (unsigned long long)p.x_prompt; st[1] = (unsigned long long)p.x_sample; st[2] = (unsigned long long)p.cache_k; st[3] = (unsigned long long)p.cache_v; st[4] = (unsigned long long)p.c; st[5] = (unsigned long long)p.c_ctx;
        st[6] = (unsigned long long)p.w_mod; st[7] = (unsigned long long)p.b_mod; st[8] = (unsigned long long)p.norm_mix; st[9] = (unsigned long long)p.norm_mlp; st[10] = (unsigned long long)p.w_in; st[11] = (unsigned long long)p.lam_q1;
        st[12] = (unsigned long long)p.lam_k1; st[13] = (unsigned long long)p.lam_q2; st[14] = (unsigned long long)p.lam_k2; st[15] = (unsigned long long)p.subln; st[16] = (unsigned long long)p.conv_w; st[17] = (unsigned long long)p.conv_b;
        st[18] = (unsigned long long)p.w_s; st[19] = (unsigned long long)p.b_s; st[20] = (unsigned long long)p.w_out; st[21] = (unsigned long long)p.w_up; st[22] = (unsigned long long)p.w_down; st[23] = (unsigned long long)p.norm_final; }
    volatile LAS unsigned* bst = (volatile LAS unsigned*)(lds + STASH_OFF + 256);
    if (threadIdx.x == 0) { bst[0] = 0u; bst[1] = 0u; if (hi - lo > 1) (void)xb_add((unsigned*)p.ws + XB_XCNT(xb_xcc_id()), 1u); }
    __syncthreads();
#define PH_IN() (lo <= ph && ph < hi)
#define PH_END() do { if (lo <= ph && ph + 1 < hi) { if (hi > 1000) cg::this_grid().sync();     \
        int ln_; asm volatile("v_mbcnt_lo_u32_b32 %0, -1, 0\n\tv_mbcnt_hi_u32_b32 %0, -1, %0" : "=v"(ln_)); unsigned char* wsb_ = ws_k; int wv_ = wave_k, Gb_ = G_k; asm volatile("" : "+s"(wsb_), "+s"(wv_), "+s"(Gb_)); \
        xcd_barrier((unsigned*)wsb_, bst, wv_ == 0 && ln_ == 0, (unsigned)Gb_); } ++ph; } while (0)
#define LAUNDER() int lane2; asm volatile("v_mbcnt_lo_u32_b32 %0, -1, 0\n\tv_mbcnt_hi_u32_b32 %0, -1, %0" : "=v"(lane2)); \
    unsigned char* ws2 = ws_k; float* out2 = out_k; int G2 = G_k, bid2 = bid_k, wave2 = wave_k; asm volatile("" : "+s"(ws2), "+s"(out2), "+s"(G2), "+s"(bid2), "+s"(wave2)); const int tid2 = wave2 * 64 + lane2; (void)tid2
    if (PH_IN()) { LAUNDER(); const Params q = load_params(lds, ws2, out2); for (int rep = 0; rep < REP_PRO; ++rep) { prologue_phase(q, lds, G2, bid2, tid2, wave2, lane2); __syncthreads(); } }
    PH_END();
    if (PH_IN()) { LAUNDER(); const Params q = load_params(lds, ws2, out2); norm_phase(q, 0, 0, G2, bid2, wave2, lane2); }
    PH_END();
    for (int L = 0; L < NLAYER; ++L) {
        if (PH_IN()) {
            LAUNDER();
            pg8::Gemm g{(const bf16_t*)(ws2 + WS_H), (const bf16_t*)(ws2 + WS_WIN) + (size_t)L * WIN_L, NTOK, INW, DM}; pg8::StaticOrder S; S.init(NTOK, INW, G2, bid2);
            pg8::EpiIn E{ws2, out2, L};
            for (int rep = 0; rep < REP_GIN; ++rep) pg8::gemm_phase<pg8::EpiIn, pg8::StaticOrder, true, true>(lds, g, S, E, wave2);
        }
        PH_END();
        if (PH_IN()) { LAUNDER(); const Params q = load_params(lds, ws2, out2); for (int rep = 0; rep < REP_MIX; ++rep) { mixer_phase(q, L, lds, G2, bid2, wave2, lane2); __syncthreads(); } }
        PH_END();
        if (PH_IN()) {
            LAUNDER();
            pg8::Gemm g{(const bf16_t*)(ws2 + WS_MIX), (const bf16_t*)(ws2 + WS_WOUT) + (size_t)L * WOUT_L, NTOK, DM, DM}; pg8::StaticOrder S; S.init(NTOK, DM, G2, bid2);
            pg8::EpiRes E{ld_param(lds, 0), ld_param(lds, 1), out2, (const float*)(ws2 + WS_MOD) + (size_t)(L * 3) * 6144 + 2 * 1024, L == 0 ? 1 : 0};
            pg8::gemm_phase<pg8::EpiRes, pg8::StaticOrder, true, true>(lds, g, S, E, wave2);
        }
        PH_END();
        if (PH_IN()) { LAUNDER(); const Params q = load_params(lds, ws2, out2); norm_phase(q, L, 1, G2, bid2, wave2, lane2); }
        PH_END();
        if (PH_IN()) {
            LAUNDER();
            pg8::Gemm g{(const bf16_t*)(ws2 + WS_H), (const bf16_t*)(ws2 + WS_WUP) + (size_t)L * WUP_L, NTOK, DFF, DM}; pg8::StaticOrder S; S.init(NTOK, DFF, G2, bid2);
            pg8::EpiUp E{(bf16_t*)(ws2 + WS_A), DFF};
            for (int rep = 0; rep < REP_GUP; ++rep) pg8::gemm_phase<pg8::EpiUp, pg8::StaticOrder, true, true>(lds, g, S, E, wave2);
        }
        PH_END();
        if (PH_IN()) {
            LAUNDER();
            pg8::Gemm g{(const bf16_t*)(ws2 + WS_A), (const bf16_t*)(ws2 + WS_WDN) + (size_t)L * WDN_L, NTOK, DM, DFF}; pg8::StaticOrder S; S.init(NTOK, DM, G2, bid2);
            pg8::EpiRes E{out2, out2, out2, (const float*)(ws2 + WS_MOD) + (size_t)(L * 3) * 6144 + 5 * 1024, 0};
            pg8::gemm_phase<pg8::EpiRes, pg8::StaticOrder, true, true>(lds, g, S, E, wave2);
        }
        PH_END();
        if (PH_IN()) { LAUNDER(); const Params q = load_params(lds, ws2, out2); if (L + 1 < NLAYER) norm_phase(q, L + 1, 0, G2, bid2, wave2, lane2); else final_norm_phase(q, G2, bid2, wave2, lane2); }
        PH_END();
    }
}
constexpr int N_PHASES = 2 + 7 * NLAYER;

extern "C" void kernel_launch(void* const* d_in, const int* in_sizes, int n_in, void* d_out, int out_size, void* d_ws, size_t ws_size, hipStream_t stream) {
    static int grid = 0;
    if (grid == 0) {
        if (n_in != 24 || ws_size < WS_END) { fprintf(stderr, "kernel_launch: unexpected n_in %d / ws_size %zu\n", n_in, ws_size); grid = -1; return; }
        int dev = 0, cus = 0, per_cu = 0;
        (void)hipGetDevice(&dev); (void)hipDeviceGetAttribute(&cus, hipDeviceAttributeMultiprocessorCount, dev);
        if (hipFuncSetAttribute((const void*)mega, hipFuncAttributeMaxDynamicSharedMemorySize, LDS_BYTES) != hipSuccess) { fprintf(stderr, "kernel_launch: hipFuncSetAttribute failed\n"); }
        if (hipOccupancyMaxActiveBlocksPerMultiprocessor(&per_cu, (const void*)mega, 512, LDS_BYTES) != hipSuccess || per_cu < 1) { fprintf(stderr, "kernel_launch: occupancy query gave %d\n", per_cu); per_cu = 1; }
        (void)hipGetLastError();
        grid = cus * per_cu;
        if (grid <= 0) grid = 256;
    }
    if (grid < 0) return;
    Params p{};
    const float** dst = (const float**)&p;
    for (int i = 0; i < 24; ++i) dst[i] = (const float*)d_in[i];
    p.out = (float*)d_out; p.ws = (unsigned char*)d_ws;
    (void)hipMemsetAsync(d_ws, 0, 16384, stream);
#if MULTI_LAUNCH
    for (int ph = 0; ph < N_PHASES; ++ph) { p.ph_lo = ph; p.ph_hi = ph + 1; hipLaunchKernelGGL(mega, dim3(grid), dim3(512), LDS_BYTES, stream, p); }
#else
    p.ph_lo = 0; p.ph_hi = N_PHASES;
    void* args[] = {&p};
    hipError_t e = hipLaunchCooperativeKernel((const void*)mega, dim3(grid), dim3(512), args, LDS_BYTES, stream);
    if (e != hipSuccess) fprintf(stderr, "kernel_launch: cooperative launch failed: %s (grid %d)\n", hipGetErrorString(e), grid);
#endif
}
```
